# Optimizing an MI355X kernel written in HIP

```python
import jax
import jax.numpy as jnp
from jax import lax
import numpy as np

D_MODEL = 4096
BATCH = 2
SEQ = 8192
DEPTH = 1

HEAD_DIM = 128
D_GMLP = D_MODEL // 2
D_NA = D_MODEL - D_GMLP
N_GMLP_HEADS = D_GMLP // HEAD_DIM
N_NA_HEADS = D_NA // HEAD_DIM
D_IN = 2 * D_GMLP + 3 * D_NA
CHUNK = 128
GRID_W = 64
WIN_ROWS_MAX = 8
WIN_COLS = 16
D_FF = 11008
CONV_W = 3
D_PLE = 256
EPS = 1e-6

kernel_name = "hybrid_gmlp_natten_convffn_block"


def rms_norm(x, g):
    xf = x.astype(jnp.float32)
    y = xf * lax.rsqrt(jnp.mean(xf * xf, axis=-1, keepdims=True) + EPS)
    return (y * g.astype(jnp.float32)).astype(x.dtype)


def chunked_spatial_gating(u, v, g_v, w_s, b_s):
    B, S, H, hd = v.shape
    n_chunks = S // CHUNK
    vc = rms_norm(v, g_v).reshape(B, n_chunks, CHUNK, H, hd)
    mixed = jnp.einsum('hij,bnjhd->bnihd', w_s, vc) + b_s.T[None, None, :, :, None]
    return u * mixed.reshape(B, S, H, hd)


def neighbourhood_attention(q, k, v, rpb):
    B, S, H, hd = q.shape
    rows = S // GRID_W
    kr = min(WIN_ROWS_MAX, rows)
    qg = q.reshape(B, rows, GRID_W, H, hd)
    kg = k.reshape(B, rows, GRID_W, H, hd)
    vg = v.reshape(B, rows, GRID_W, H, hd)
    col = jnp.arange(GRID_W)
    col_start = jnp.clip(col - WIN_COLS // 2, 0, GRID_W - WIN_COLS)
    col_idx = col_start[:, None] + jnp.arange(WIN_COLS)[None, :]
    dc = col_idx - col[:, None] + (WIN_COLS - 1)
    rpb_col = rpb[:, :, dc]
    scale = HEAD_DIM ** -0.5

    def one_row(r):
        rs = jnp.clip(r - kr // 2, 0, rows - kr)
        q_r = lax.dynamic_index_in_dim(qg, r, axis=1, keepdims=False)
        k_blk = lax.dynamic_slice_in_dim(kg, rs, kr, axis=1)
        v_blk = lax.dynamic_slice_in_dim(vg, rs, kr, axis=1)
        k_nb = k_blk[:, :, col_idx]
        v_nb = v_blk[:, :, col_idx]
        dr = rs + jnp.arange(kr) - r + (WIN_ROWS_MAX - 1)
        bias = jnp.transpose(rpb_col[:, dr], (0, 2, 1, 3))
        s = jnp.einsum('bqhd,brqchd->bhqrc', q_r, k_nb,
                       preferred_element_type=jnp.float32) * scale
        s = s + bias[None].astype(jnp.float32)
        pr = jax.nn.softmax(s.reshape(B, H, GRID_W, kr * WIN_COLS), axis=-1)
        pr = pr.reshape(B, H, GRID_W, kr, WIN_COLS).astype(v.dtype)
        return jnp.einsum('bhqrc,brqchd->bqhd', pr, v_nb)

    out = lax.map(one_row, jnp.arange(rows))
    return jnp.moveaxis(out, 0, 1).reshape(B, S, H, hd)


def conv_ffn(xn, w_up, conv_w, conv_b, w_down):
    S = xn.shape[1]
    up = xn @ w_up
    half = CONV_W // 2
    padded = jnp.pad(up, ((0, 0), (half, half), (0, 0)))
    c = conv_b + sum(padded[:, j:j + S] * conv_w[j] for j in range(CONV_W))
    gate, val = jnp.split(c, 2, axis=-1)
    return (jax.nn.gelu(gate, approximate=False) * val) @ w_down


def setup_inputs(seed: int = 0) -> dict:
    key = jax.random.key(seed)
    ks = jax.random.split(key, 22)
    f32 = jnp.float32
    L = DEPTH

    def nrm(k, shape, scale):
        return jax.random.normal(k, shape, f32) * scale

    def gain(k, shape):
        return 1.0 + 0.05 * jax.random.normal(k, shape, f32)

    return {
        "x": nrm(ks[0], (BATCH, SEQ, D_MODEL), 1.0),
        "p": nrm(ks[1], (DEPTH, BATCH, SEQ, D_PLE), 1.0),
        "norm_mix_g": gain(ks[2], (L, D_MODEL)),
        "w_in": nrm(ks[3], (L, D_MODEL, D_IN), D_MODEL ** -0.5),
        "gmlp_v_g": gain(ks[4], (L, N_GMLP_HEADS, HEAD_DIM)),
        "gmlp_ws": nrm(ks[5], (L, N_GMLP_HEADS, CHUNK, CHUNK), CHUNK ** -0.5),
        "gmlp_bs": 1.0 + 0.1 * jax.random.normal(ks[6], (L, N_GMLP_HEADS, CHUNK), f32),
        "q_norm_g": gain(ks[7], (L, HEAD_DIM)),
        "k_norm_g": gain(ks[8], (L, HEAD_DIM)),
        "na_rpb": nrm(ks[9], (L, N_NA_HEADS, 2 * WIN_ROWS_MAX - 1, 2 * WIN_COLS - 1), 0.2),
        "out_norm_a_g": gain(ks[10], (L, N_GMLP_HEADS, HEAD_DIM)),
        "out_norm_b_g": gain(ks[11], (L, N_NA_HEADS, HEAD_DIM)),
        "w_out": nrm(ks[12], (L, D_MODEL, D_MODEL), D_MODEL ** -0.5),
        "norm_ffn_g": gain(ks[13], (L, D_MODEL)),
        "w_up": nrm(ks[14], (L, D_MODEL, 2 * D_FF), D_MODEL ** -0.5),
        "conv_w": nrm(ks[15], (L, CONV_W, 2 * D_FF), CONV_W ** -0.5),
        "conv_b": nrm(ks[16], (L, 2 * D_FF), 0.01),
        "w_down": nrm(ks[17], (L, D_FF, D_MODEL), D_FF ** -0.5),
        "norm_ple_g": gain(ks[18], (L, D_MODEL)),
        "w_ple_gate": nrm(ks[19], (L, D_MODEL, D_MODEL), D_MODEL ** -0.5),
        "w_ple_proj": nrm(ks[20], (L, D_PLE, D_MODEL), D_PLE ** -0.5),
        "ple_post_g": gain(ks[21], (L, D_MODEL)),
    }


def reference(x, p, norm_mix_g, w_in, gmlp_v_g, gmlp_ws, gmlp_bs, q_norm_g, k_norm_g,
              na_rpb, out_norm_a_g, out_norm_b_g, w_out, norm_ffn_g, w_up, conv_w,
              conv_b, w_down, norm_ple_g, w_ple_gate, w_ple_proj, ple_post_g):
    B, S, _ = x.shape
    h = x
    for i in range(DEPTH):
        hn = rms_norm(h, norm_mix_g[i])
        z = jnp.einsum('bsd,de->bse', hn, w_in[i])
        zg = jax.nn.gelu(z[..., :2 * D_GMLP], approximate=False)
        u = zg[..., :D_GMLP].reshape(B, S, N_GMLP_HEADS, HEAD_DIM)
        vs = zg[..., D_GMLP:].reshape(B, S, N_GMLP_HEADS, HEAD_DIM)
        q, k, v = jnp.split(z[..., 2 * D_GMLP:], 3, axis=-1)
        q = rms_norm(q.reshape(B, S, N_NA_HEADS, HEAD_DIM), q_norm_g[i])
        k = rms_norm(k.reshape(B, S, N_NA_HEADS, HEAD_DIM), k_norm_g[i])
        v = v.reshape(B, S, N_NA_HEADS, HEAD_DIM)
        a_out = chunked_spatial_gating(u, vs, gmlp_v_g[i], gmlp_ws[i], gmlp_bs[i])
        b_out = neighbourhood_attention(q, k, v, na_rpb[i])
        mix = jnp.concatenate([
            rms_norm(a_out, out_norm_a_g[i]).reshape(B, S, D_GMLP),
            rms_norm(b_out, out_norm_b_g[i]).reshape(B, S, D_NA)], axis=-1)
        h = h + jnp.einsum('bse,ed->bsd', mix, w_out[i])
        h = h + conv_ffn(rms_norm(h, norm_ffn_g[i]), w_up[i], conv_w[i], conv_b[i], w_down[i])
        gate = jax.nn.sigmoid(jnp.einsum('bsd,de->bse', rms_norm(h, norm_ple_g[i]), w_ple_gate[i]))
        e = rms_norm(jnp.einsum('bsk,kd->bsd', p[i], w_ple_proj[i]), ple_post_g[i])
        h = h + gate * e
    return h
```

```cpp
#include <hip/hip_runtime.h>
#include <cstdio>
#include <cstdint>

#ifndef MK_N_LAUNCHES
#define MK_N_LAUNCHES 1
#endif

#ifndef ASYM_WAIT
#define ASYM_WAIT 0
#endif
#ifndef DPP_OLD_PREV
#define DPP_OLD_PREV 0
#endif
#ifndef REP0
#define REP0 1
#endif
#ifndef REP1
#define REP1 1
#endif
#ifndef REP7
#define REP7 1
#endif
#ifndef REP3
#define REP3 1
#endif
#ifndef REP4
#define REP4 1
#endif
#ifndef PROBE_D
#define PROBE_D 0
#endif
#ifndef PROBE_STAGGER
#define PROBE_STAGGER 200
#endif
#ifndef REP2
#define REP2 1
#endif
#define LAS __attribute__((address_space(3)))
#define GAS __attribute__((address_space(1)))
typedef unsigned short bf16_t;
typedef short bf16x8 __attribute__((ext_vector_type(8)));
typedef short s16x4 __attribute__((ext_vector_type(4)));
typedef float f32x4 __attribute__((ext_vector_type(4)));
typedef float f32x2 __attribute__((ext_vector_type(2)));
typedef unsigned u32x4 __attribute__((ext_vector_type(4)));
typedef unsigned u32x2 __attribute__((ext_vector_type(2)));
typedef int i32x4 __attribute__((ext_vector_type(4)));
typedef int i32x8 __attribute__((ext_vector_type(8)));

constexpr int BATCH = 2, SEQ = 8192, M = BATCH * SEQ, DM = 4096, DG = 2048, DIN = 10240, DFF = 11008, DUP = 2 * DFF, DPLE = 256, HD = 128, NH = 16;
constexpr float EPS = 1e-6f;
constexpr float LOG2E = 1.4426950408889634f;
constexpr int NPH = 11;

constexpr size_t MiB = 1u << 20;
constexpr size_t WS_CTL = 0, CTL_ZERO_BYTES = 1 * MiB;
constexpr size_t WS_STA = 1 * MiB, WS_STB = 2 * MiB, WS_STE = 3 * MiB;
constexpr size_t WS_WS = 4 * MiB;
constexpr size_t WS_PB = 5 * MiB;
constexpr size_t WS_WP = 13 * MiB;
constexpr size_t WS_EDGE = 16 * MiB;
constexpr size_t WS_WIN = 38 * MiB;
constexpr size_t WS_WOUT = 118 * MiB;
constexpr size_t WS_WUP = 150 * MiB;
constexpr size_t WS_WDN = 322 * MiB;
constexpr size_t WS_WG = 408 * MiB;
constexpr size_t WS_XA = 440 * MiB;
constexpr size_t WS_E = 568 * MiB;
constexpr size_t WS_Z = 696 * MiB;
constexpr size_t WS_MIX = 1016 * MiB;
constexpr size_t WS_ACT = 696 * MiB;
constexpr size_t WS_A8 = 1048 * MiB;
constexpr size_t WS_A8H = 1144 * MiB;
constexpr size_t WS_END = 1208 * MiB;
constexpr size_t WS_CMAX = 256 * 1024;
constexpr size_t WS_RSF = 4 * MiB + 512 * 1024;
constexpr int I8_T0 = 1, I8_T1 = 4;
constexpr int I8_R0 = 2048 * I8_T0, I8_R1 = 2048 * I8_T1;
constexpr size_t WS_CMAX2 = 384 * 1024;
constexpr size_t WS_CMAXG = 432 * 1024;
constexpr size_t WS_RSB = WS_RSF + 128 * 1024;
constexpr size_t WS_RSN = WS_RSF + 64 * 1024;
constexpr size_t WS_WIN8 = 38 * MiB + (size_t)I8_R0 * 4096;
static_assert(WS_CMAX2 >= 256 * 1024 + (size_t)2 * 11008 * 4 && WS_CMAX2 + 10240 * 4 <= 1 * MiB, "cmax arrays inside the zeroed MiB");
static_assert(WS_ACT + (size_t)M * DFF * 2 <= WS_A8 && WS_A8 + (size_t)M * DM <= WS_A8H && WS_A8H + (size_t)M * DM <= WS_END, "fp8 h2 copy, int8 h1 copy");
constexpr float WG_SCALE = 256.0f;
static_assert(WS_ACT + (size_t)M * DFF * 2 <= WS_END, "act overlay");
static_assert(WS_EDGE + (size_t)64 * 4 * DUP * 4 <= WS_WIN, "edge buffer");

constexpr int CW_TMO = 0, CW_BAR = 4096;

constexpr int RING_BYTES = 131072;
constexpr int EPI_P = 131072;
constexpr int EPI_H = 139264;
constexpr int EPI_RS = 147456;
constexpr int MISC_OFF = 149504;
constexpr int LDS_BYTES = 151552;

__device__ __forceinline__ int lane_id() { int l; asm volatile("v_mbcnt_lo_u32_b32 %0, -1, 0\n\tv_mbcnt_hi_u32_b32 %0, -1, %0" : "=v"(l)); return l; }
namespace pg8 {
constexpr int BM = 256, BK = 64, HALF = 128, HTB = HALF * BK * 2, STAGE_BYTES = 8 * HTB, NXCD = 8, WGM = 8;
__host__ __device__ __forceinline__ int lds_byte(int r, int c) { const int st = (r >> 4) * 2 + (c >> 5), rr = r & 15, cc = c & 31, ob = rr * 64 + cc * 2; return st * 1024 + (ob ^ (((ob >> 9) & 1) << 5)); }
__host__ __device__ __forceinline__ void stage_rc(int b, int& R, int& C) { const int st = b / 1024, sb = b % 1024, swz = sb ^ (((sb >> 9) & 1) << 5); R = (st >> 1) * 16 + swz / 64; C = (st & 1) * 32 + (swz % 64) / 2; }
__host__ __device__ __forceinline__ int perm32(int rho) { const int n = rho >> 4, i = rho & 15; return 8 * (i >> 2) + 4 * n + (i & 3); }
struct Unit { int pm, pn; };
struct Gemm { const bf16_t* A; const bf16_t* Bt; int M, N, K, ld; };
struct StaticOrder {
    int nM, nN, nwg, G, c;
    __host__ __device__ void init(int M_, int N_, int G_, int c_) { nM = M_ / BM; nN = N_ / BM; nwg = nM * nN; G = G_; c = c_; }
    __host__ __device__ bool next(int i, Unit& u) const {
        const long L = (long)i * G + c; if (L >= nwg) return false;
        int wgid = (int)L; { const int q = nwg / NXCD, r = nwg % NXCD, xcd = wgid % NXCD, off = wgid / NXCD; wgid = (xcd < r ? xcd * (q + 1) : r * (q + 1) + (xcd - r) * q) + off; }
        const int nig = WGM * nN, gid = wgid / nig, fm = gid * WGM, gsz = (nM - fm) < WGM ? (nM - fm) : WGM;
        u.pm = fm + ((wgid % nig) % gsz); u.pn = (wgid % nig) / gsz; return true;
    }
};
__device__ __forceinline__ unsigned cvt_pk_bf16(float lo, float hi) { unsigned r; asm volatile("v_cvt_pk_bf16_f32 %0, %1, %2" : "=v"(r) : "v"(lo), "v"(hi)); return r; }
__device__ __forceinline__ f32x2 gelu_pk(f32x2 v) {
    const f32x2 av = __builtin_elementwise_abs(v), d = av * 0.2316418882f + 1.0f;
    f32x2 t; t.x = __builtin_amdgcn_rcpf(d.x); t.y = __builtin_amdgcn_rcpf(d.y);
    f32x2 q = t * 0.5307027145f + (-0.7265760135f); q = q * t + 0.7107068705f; q = q * t + (-0.142248368f); q = q * t + 0.127414796f; q = q * t;
    const f32x2 s = (v * v) * (-0.72134752044f);
    f32x2 e; e.x = __builtin_amdgcn_exp2f(s.x); e.y = __builtin_amdgcn_exp2f(s.y);
    const f32x2 m = v * (q * e), r = v - m;
    f32x2 o; o.x = v.x < 0.f ? m.x : r.x; o.y = v.y < 0.f ? m.y : r.y; return o;
}
__device__ __forceinline__ f32x4 gelu4(f32x4 v) { const f32x2 a = gelu_pk((f32x2){v[0], v[1]}), b = gelu_pk((f32x2){v[2], v[3]}); return (f32x4){a.x, a.y, b.x, b.y}; }
__device__ __forceinline__ float sumsq4(f32x4 v) { return (v[0] * v[0] + v[1] * v[1]) + (v[2] * v[2] + v[3] * v[3]); }
__device__ __forceinline__ float xsum_fq(float s) { s += __shfl_xor(s, 16); s += __shfl_xor(s, 32); return s; }
#define EPI_BAR() do { asm volatile("s_waitcnt lgkmcnt(0)" ::: "memory"); __builtin_amdgcn_s_barrier(); asm volatile("" ::: "memory"); } while (0)


template <bool I8>
struct EpiZ {
    bf16_t* Z; const float* gv; const float* gq; const float* gk; LAS float* P; const float* rsn; const unsigned* cm; LAS float* RS; int* rs_pm;
    __device__ __forceinline__ void operator()(f32x4 (&acc)[2][2][4][2], const Unit& u, const int wr, const int wc, const int wid) const {
        const int lane = lane_id(), fr = lane & 15, fq = lane >> 4, tid = wid * 64 + lane;
        const int t = u.pn >> 3, ct = (u.pn & 7) * 256;
        if constexpr (I8) {
            if (__builtin_amdgcn_readfirstlane(*rs_pm) != u.pm) {
                if (tid < 256) RS[tid] = rsn[u.pm * BM + tid] * (1.0f / 127.0f);
                EPI_BAR(); *rs_pm = u.pm;
            }
            float rr[2][4];
#pragma unroll
            for (int ai = 0; ai < 2; ++ai)
#pragma unroll
                for (int m = 0; m < 4; ++m) rr[ai][m] = RS[ai * HALF + wr * 64 + m * 16 + fr];
#pragma unroll
            for (int bj = 0; bj < 2; ++bj)
#pragma unroll
                for (int n = 0; n < 2; ++n) {
                    const u32x4 cmb = *(const u32x4*)(cm + u.pn * 256 + bj * 128 + wc * 32 + 8 * fq + 4 * n);
                    const f32x4 ws4 = {__uint_as_float(cmb.x), __uint_as_float(cmb.y), __uint_as_float(cmb.z), __uint_as_float(cmb.w)};
#pragma unroll
                    for (int ai = 0; ai < 2; ++ai)
#pragma unroll
                        for (int m = 0; m < 4; ++m) { acc[ai][bj][m][n] = __builtin_convertvector(__builtin_bit_cast(i32x4, acc[ai][bj][m][n]), f32x4) * (ws4 * rr[ai][m]);
                            asm volatile("" : "+v"(acc[ai][bj][m][n])); }
                    __builtin_amdgcn_sched_barrier(0);
                }
        }
        if (t <= 1) {
#pragma unroll
            for (int ai = 0; ai < 2; ++ai)
#pragma unroll
                for (int bj = 0; bj < 2; ++bj)
#pragma unroll
                    for (int m = 0; m < 4; ++m)
#pragma unroll
                        for (int n = 0; n < 2; ++n) acc[ai][bj][m][n] = gelu4(acc[ai][bj][m][n]);
        }
        if (t >= 1 && t <= 3) {
#pragma unroll
            for (int ai = 0; ai < 2; ++ai)
#pragma unroll
                for (int m = 0; m < 4; ++m)
#pragma unroll
                    for (int bj = 0; bj < 2; ++bj) {
                        float s = sumsq4(acc[ai][bj][m][0]) + sumsq4(acc[ai][bj][m][1]); s = xsum_fq(s);
                        if (fq == 0) P[(bj * 256 + ai * 128 + wr * 64 + m * 16 + fr) * 4 + wc] = s;
                    }
            EPI_BAR();
            const float* gsrc = (t == 1) ? (gv + (u.pn & 7) * 256) : (t == 2 ? gq : gk);
#pragma unroll
            for (int bj = 0; bj < 2; ++bj) {
                const float* gp = gsrc + ((t == 1) ? bj * 128 : 0) + wc * 32 + 8 * fq;
                const f32x4 g0 = *(const f32x4*)gp, g1 = *(const f32x4*)(gp + 4);
#pragma unroll
                for (int ai = 0; ai < 2; ++ai)
#pragma unroll
                    for (int m = 0; m < 4; ++m) {
                        const f32x4 p4 = *(const LAS f32x4*)&P[(bj * 256 + ai * 128 + wr * 64 + m * 16 + fr) * 4];
                        const float r = rsqrtf(((p4[0] + p4[1]) + (p4[2] + p4[3])) * (1.0f / 128.0f) + EPS);
                        acc[ai][bj][m][0] = acc[ai][bj][m][0] * r * g0; acc[ai][bj][m][1] = acc[ai][bj][m][1] * r * g1;
                    }
            }
        }
        bf16_t* base = Z + (size_t)t * M * DG;
#pragma unroll
        for (int ai = 0; ai < 2; ++ai)
#pragma unroll
            for (int m = 0; m < 4; ++m) {
                bf16_t* rowp = base + (size_t)(u.pm * BM + ai * HALF + wr * 64 + m * 16 + fr) * DG + ct + wc * 32 + 8 * fq;
#pragma unroll
                for (int bj = 0; bj < 2; ++bj) {
                    const f32x4 v0 = acc[ai][bj][m][0], v1 = acc[ai][bj][m][1];
                    u32x4 w; w.x = cvt_pk_bf16(v0[0], v0[1]); w.y = cvt_pk_bf16(v0[2], v0[3]); w.z = cvt_pk_bf16(v1[0], v1[1]); w.w = cvt_pk_bf16(v1[2], v1[3]);
                    *(u32x4*)(rowp + bj * HALF) = w;
                }
            }
    }
};

__device__ __forceinline__ unsigned pk4_fp8(float a, float b, float c, float d) {
    int p = 0; p = __builtin_amdgcn_cvt_pk_fp8_f32(a, b, p, false); p = __builtin_amdgcn_cvt_pk_fp8_f32(c, d, p, true); return (unsigned)p; }
__device__ __forceinline__ unsigned pk4_i8(f32x4 v) {
    const int a = (int)__builtin_rintf(v[0]), b = (int)__builtin_rintf(v[1]), c = (int)__builtin_rintf(v[2]), d = (int)__builtin_rintf(v[3]);
    return (unsigned)(a & 255) | ((unsigned)(b & 255) << 8) | ((unsigned)(c & 255) << 16) | ((unsigned)d << 24); }
__device__ __forceinline__ void bf8_to_f32(const u32x4 w, f32x4& a, f32x4& b) {
    a[0] = __uint_as_float(w.x << 16); a[1] = __uint_as_float(w.x & 0xffff0000u); a[2] = __uint_as_float(w.y << 16); a[3] = __uint_as_float(w.y & 0xffff0000u);
    b[0] = __uint_as_float(w.z << 16); b[1] = __uint_as_float(w.z & 0xffff0000u); b[2] = __uint_as_float(w.w << 16); b[3] = __uint_as_float(w.w & 0xffff0000u);
}
struct EpiRes {
    const float* base; const bf16_t* baseb; float* outf; bf16_t* outb; float* stats; int ldc; LAS float* P; unsigned char* out8 = nullptr;
    template <int MB>
    __device__ __forceinline__ void batch(f32x4 (&acc)[2][2][4][2], const Unit& u, const int ai, const int bj, const int mb, const int wr, const int fr, const int col0, float (&ss)[4]) const {
        f32x4 b0[MB], b1[MB]; u32x4 bb[MB];
#pragma unroll
        for (int q = 0; q < MB; ++q) { const int m = mb + q;
            const size_t off = (size_t)(u.pm * BM + ai * HALF + wr * 64 + m * 16 + fr) * ldc + col0 + bj * HALF;
            if (base) { b0[q] = *(const f32x4*)(base + off); b1[q] = *(const f32x4*)(base + off + 4); }
            if (baseb) bb[q] = *(const u32x4*)(baseb + off);
        }
#pragma unroll
        for (int q = 0; q < MB; ++q) { const int m = mb + q;
            const size_t off = (size_t)(u.pm * BM + ai * HALF + wr * 64 + m * 16 + fr) * ldc + col0 + bj * HALF;
            f32x4 v0 = acc[ai][bj][m][0], v1 = acc[ai][bj][m][1];
            if (base) { v0 += b0[q]; v1 += b1[q]; }
            if (baseb) { f32x4 r0, r1; bf8_to_f32(bb[q], r0, r1); v0 += r0; v1 += r1; }
            if (outf) { *(f32x4*)(outf + off) = v0; *(f32x4*)(outf + off + 4) = v1; }
            if (outb) { u32x4 w; w.x = cvt_pk_bf16(v0[0], v0[1]); w.y = cvt_pk_bf16(v0[2], v0[3]); w.z = cvt_pk_bf16(v1[0], v1[1]); w.w = cvt_pk_bf16(v1[2], v1[3]); *(u32x4*)(outb + off) = w; }
            if (out8) { u32x2 w8; w8.x = pk4_fp8(v0[0], v0[1], v0[2], v0[3]); w8.y = pk4_fp8(v1[0], v1[1], v1[2], v1[3]); *(u32x2*)(out8 + off) = w8; }
            ss[m] += sumsq4(v0) + sumsq4(v1);
        }
    }
    __device__ __forceinline__ void operator()(f32x4 (&acc)[2][2][4][2], const Unit& u, const int wr, const int wc, const int wid) const {
        const int lane = lane_id(), fr = lane & 15, fq = lane >> 4, tid = wid * 64 + lane;
        const int col0 = u.pn * BM + wc * 32 + 8 * fq;
#pragma unroll
        for (int ai = 0; ai < 2; ++ai) {
            float ss[4] = {0.f, 0.f, 0.f, 0.f};
#pragma unroll
            for (int bj = 0; bj < 2; ++bj) {
                if (base) { batch<2>(acc, u, ai, bj, 0, wr, fr, col0, ss); batch<2>(acc, u, ai, bj, 2, wr, fr, col0, ss); }
                else batch<4>(acc, u, ai, bj, 0, wr, fr, col0, ss);
            }
            if (stats) {
#pragma unroll
                for (int m = 0; m < 4; ++m) { const float sx = xsum_fq(ss[m]); if (fq == 0) P[(ai * HALF + wr * 64 + m * 16 + fr) * 4 + wc] = sx; }
            }
        }
        if (stats) {
            EPI_BAR();
            if (tid < 256) { const f32x4 p4 = *(const LAS f32x4*)&P[tid * 4]; stats[(size_t)u.pn * M + u.pm * BM + tid] = (p4[0] + p4[1]) + (p4[2] + p4[3]); }
        }
    }
};

__device__ __forceinline__ float rstd_from_parts(const float* st, int row) {
    float s = 0.f;
#pragma unroll
    for (int j = 0; j < 16; ++j) s += st[(size_t)j * M + row];
    return rsqrtf(s * (1.0f / 4096.0f) + EPS);
}
__device__ __forceinline__ float row_prev(float v) { return __builtin_bit_cast(float, __builtin_amdgcn_update_dpp(0, __builtin_bit_cast(int, v), 0x121, 0xF, 0xF, true)); }
__device__ __forceinline__ float row_next(float v) { return __builtin_bit_cast(float, __builtin_amdgcn_update_dpp(0, __builtin_bit_cast(int, v), 0x12F, 0xF, 0xF, true)); }

struct EpiUp {
    bf16_t* act; const float* rsf; const unsigned* cmax; const float* cw; const float* cb; float* edge; LAS float* RS; LAS f32x4* H; int* rs_pm; LAS float* PRM;
    __device__ __forceinline__ void operator()(f32x4 (&acc)[2][2][4][2], const Unit& u, const int wr, const int wc, const int wid) const {
        const int lane = lane_id(), fr = lane & 15, fq = lane >> 4, tid = wid * 64 + lane;
        if (__builtin_amdgcn_readfirstlane(*rs_pm) != u.pm) {
            if (tid < 256) RS[tid] = rsf[u.pm * BM + tid] * (1.0f / 127.0f);
            EPI_BAR(); *rs_pm = u.pm;
        }
        {
            float rr[2][4];
#pragma unroll
            for (int ai = 0; ai < 2; ++ai)
#pragma unroll
                for (int m = 0; m < 4; ++m) rr[ai][m] = RS[ai * HALF + wr * 64 + m * 16 + fr];
#pragma unroll
            for (int bj = 0; bj < 2; ++bj)
#pragma unroll
                for (int n = 0; n < 2; ++n) {
                    const u32x4 cmb = *(const u32x4*)(cmax + u.pn * 128 + wc * 32 + 8 * fq + 4 * n + bj * DFF);
                    const f32x4 ws4 = {__uint_as_float(cmb.x), __uint_as_float(cmb.y), __uint_as_float(cmb.z), __uint_as_float(cmb.w)};
#pragma unroll
                    for (int ai = 0; ai < 2; ++ai)
#pragma unroll
                        for (int m = 0; m < 4; ++m) { acc[ai][bj][m][n] = __builtin_convertvector(__builtin_bit_cast(i32x4, acc[ai][bj][m][n]), f32x4) * (ws4 * rr[ai][m]);
                            asm volatile("" : "+v"(acc[ai][bj][m][n])); }
                    __builtin_amdgcn_sched_barrier(0);
                }
        }
        if (tid < 256) { const int ch = (tid < 128) ? u.pn * 128 + tid : DFF + u.pn * 128 + (tid - 128);
            PRM[tid] = cw[ch]; PRM[256 + tid] = cw[DUP + ch]; PRM[512 + tid] = cw[2 * DUP + ch]; PRM[768 + tid] = cb[ch]; }
#pragma unroll
        for (int ai = 0; ai < 2; ++ai) {
            if (fr == 0) {
#pragma unroll
                for (int bj = 0; bj < 2; ++bj)
#pragma unroll
                    for (int n = 0; n < 2; ++n) H[((((ai * 2 + wr) * 2 + 0) * 4 + wc) * 4 + fq) * 4 + bj * 2 + n] = acc[ai][bj][0][n];
            }
            if (fr == 15) {
#pragma unroll
                for (int bj = 0; bj < 2; ++bj)
#pragma unroll
                    for (int n = 0; n < 2; ++n) H[((((ai * 2 + wr) * 2 + 1) * 4 + wc) * 4 + fq) * 4 + bj * 2 + n] = acc[ai][bj][3][n];
            }
        }
        {
            const int chan = u.pn * 128 + wc * 32 + 8 * fq;
            if (wr == 0 && fr < 2) {
                float* ep = edge + ((size_t)u.pm * 4 + fr) * DUP + chan;
#pragma unroll
                for (int bj = 0; bj < 2; ++bj)
#pragma unroll
                    for (int n = 0; n < 2; ++n) *(f32x4*)(ep + bj * DFF + 4 * n) = acc[0][bj][0][n];
            }
            if (wr == 1 && fr >= 14) {
                float* ep = edge + ((size_t)u.pm * 4 + 2 + (fr - 14)) * DUP + chan;
#pragma unroll
                for (int bj = 0; bj < 2; ++bj)
#pragma unroll
                    for (int n = 0; n < 2; ++n) *(f32x4*)(ep + bj * DFF + 4 * n) = acc[1][bj][3][n];
            }
        }
        EPI_BAR();
        const f32x4 z4 = {0.f, 0.f, 0.f, 0.f};
        u32x2 keep[2][4];
#pragma unroll
        for (int n = 0; n < 2; ++n) {
            const int cg0 = u.pn * 128 + wc * 32 + 8 * fq + 4 * n;
#pragma unroll
            for (int ai = 0; ai < 2; ++ai) {
                f32x4 cgate[4];
#pragma unroll
                for (int bj = 0; bj < 2; ++bj) {
                    const int ch = cg0 + bj * DFF;
                    const int pl = bj * 128 + wc * 32 + 8 * fq + 4 * n; (void)ch;
                    const f32x4 W0 = *(const LAS f32x4*)(PRM + pl), W1 = *(const LAS f32x4*)(PRM + 256 + pl), W2 = *(const LAS f32x4*)(PRM + 512 + pl), CB = *(const LAS f32x4*)(PRM + 768 + pl);
                    f32x4 hp, hn;
                    if (wr == 1) hp = H[((((ai * 2 + 0) * 2 + 1) * 4 + wc) * 4 + fq) * 4 + bj * 2 + n];
                    else if (ai == 1) hp = H[((((0 * 2 + 1) * 2 + 1) * 4 + wc) * 4 + fq) * 4 + bj * 2 + n];
                    else hp = z4;
                    if (wr == 0) hn = H[((((ai * 2 + 1) * 2 + 0) * 4 + wc) * 4 + fq) * 4 + bj * 2 + n];
                    else if (ai == 0) hn = H[((((1 * 2 + 0) * 2 + 0) * 4 + wc) * 4 + fq) * 4 + bj * 2 + n];
                    else hn = z4;
                    f32x4 tprow = hp;
                    f32x4 un;
#pragma unroll
                    for (int e = 0; e < 4; ++e) un[e] = row_next(acc[ai][bj][0][n][e]);
#pragma unroll
                    for (int m = 0; m < 4; ++m) {
                        const f32x4 xv = acc[ai][bj][m][n];
                        f32x4 t, unx = hn;
#pragma unroll
                        for (int e = 0; e < 4; ++e) t[e] = row_prev(xv[e]);
                        if (m < 3) {
#pragma unroll
                            for (int e = 0; e < 4; ++e) unx[e] = row_next(acc[ai][bj][m < 3 ? m + 1 : 3][n][e]);
                        }
#if DPP_OLD_PREV
                        f32x4 pv;
#pragma unroll
                        for (int e = 0; e < 4; ++e) pv[e] = __builtin_bit_cast(float, __builtin_amdgcn_update_dpp(__builtin_bit_cast(int, tprow[e]), __builtin_bit_cast(int, xv[e]), 0x111, 0xF, 0xF, false));
#else
                        const f32x4 pv = (fr == 0) ? tprow : t;
#endif
                        const f32x4 nv = (fr == 15) ? unx : un;
                        const f32x4 c = CB + W0 * pv + W1 * xv + W2 * nv;
                        tprow = t; un = unx;
                        if (bj == 0) cgate[m] = c;
                        else {
                            const f32x4 a = gelu4(cgate[m]) * c;
                            u32x2 w; w.x = cvt_pk_bf16(a[0], a[1]); w.y = cvt_pk_bf16(a[2], a[3]);
                            if (n == 0) keep[ai][m] = w;
                            else { u32x4 w4; w4.x = keep[ai][m].x; w4.y = keep[ai][m].y; w4.z = w.x; w4.w = w.y;
                                *(u32x4*)(act + (size_t)(u.pm * BM + ai * HALF + wr * 64 + m * 16 + fr) * DFF + cg0 - 4) = w4; }
                        }
                    }
                }
            }
        }
    }
};

struct EpiGate {
    float* out; const bf16_t* HB; const bf16_t* E; const float* rsb; const float* statsE; const float* gpost; LAS float* RS; int* rs_pm; const unsigned* cmg;
    __device__ __forceinline__ void operator()(f32x4 (&acc)[2][2][4][2], const Unit& u, const int wr, const int wc, const int wid) const {
        const int lane = lane_id(), fr = lane & 15, fq = lane >> 4, tid = wid * 64 + lane;
        if (__builtin_amdgcn_readfirstlane(*rs_pm) != u.pm) {
            if (tid < 256) { RS[tid] = rsb[u.pm * BM + tid] * (-LOG2E / 127.0f); RS[256 + tid] = rstd_from_parts(statsE, u.pm * BM + tid); }
            EPI_BAR(); *rs_pm = u.pm;
        }
        const int col0 = u.pn * BM + wc * 32 + 8 * fq;
#pragma unroll
        for (int bj = 0; bj < 2; ++bj) {
            const f32x4 g0 = *(const f32x4*)(gpost + col0 + bj * HALF), g1 = *(const f32x4*)(gpost + col0 + bj * HALF + 4);
            const u32x4 cb0 = *(const u32x4*)(cmg + col0 + bj * HALF), cb1 = *(const u32x4*)(cmg + col0 + bj * HALF + 4);
            const f32x4 c0 = {__uint_as_float(cb0.x), __uint_as_float(cb0.y), __uint_as_float(cb0.z), __uint_as_float(cb0.w)}, c1 = {__uint_as_float(cb1.x), __uint_as_float(cb1.y), __uint_as_float(cb1.z), __uint_as_float(cb1.w)};
#pragma unroll
            for (int ai = 0; ai < 2; ++ai) {
                u32x4 eL[4], hL[4];
#pragma unroll
                for (int m = 0; m < 4; ++m) {
                    const size_t off = (size_t)(u.pm * BM + ai * HALF + wr * 64 + m * 16 + fr) * DM + col0 + bj * HALF;
                    eL[m] = *(const u32x4*)(E + off); hL[m] = *(const u32x4*)(HB + off);
                }
#pragma unroll
                for (int m = 0; m < 4; ++m) {
                    const int rl = ai * HALF + wr * 64 + m * 16 + fr; const float r3 = RS[rl], re = RS[256 + rl];
                    const size_t off = (size_t)(u.pm * BM + rl) * DM + col0 + bj * HALF;
                    f32x4 e0, e1, h0, h1;
                    bf8_to_f32(eL[m], e0, e1);
                    bf8_to_f32(hL[m], h0, h1);
                    const f32x4 z0 = __builtin_convertvector(__builtin_bit_cast(i32x4, acc[ai][bj][m][0]), f32x4) * (c0 * r3), z1 = __builtin_convertvector(__builtin_bit_cast(i32x4, acc[ai][bj][m][1]), f32x4) * (c1 * r3);
                    f32x4 s0, s1;
#pragma unroll
                    for (int e = 0; e < 4; ++e) {
                        s0[e] = __builtin_amdgcn_rcpf(1.0f + __builtin_amdgcn_exp2f(z0[e]));
                        s1[e] = __builtin_amdgcn_rcpf(1.0f + __builtin_amdgcn_exp2f(z1[e]));
                    }
                    *(f32x4*)(out + off) = h0 + s0 * (e0 * re * g0);
                    *(f32x4*)(out + off + 4) = h1 + s1 * (e1 * re * g1);
                }
            }
        }
    }
};

struct EpiNone {
    float* sink;
    __device__ __forceinline__ void operator()(f32x4 (&acc)[2][2][4][2], const Unit& u, const int wr, const int wc, const int wid) const {
        const int lane = lane_id(), fr = lane & 15, fq = lane >> 4, tid = wid * 64 + lane;
        f32x4 s = {0.f, 0.f, 0.f, 0.f};
#pragma unroll
        for (int ai = 0; ai < 2; ++ai)
#pragma unroll
            for (int bj = 0; bj < 2; ++bj)
#pragma unroll
                for (int m = 0; m < 4; ++m)
#pragma unroll
                    for (int n = 0; n < 2; ++n) s += acc[ai][bj][m][n];
        if ((s[0] + s[1]) + (s[2] + s[3]) == 123456.789f) sink[tid] = 1.f;
    }
};
struct TailOrder : StaticOrder { int cskip;
    __host__ __device__ void init_tail(int M_, int N_, int G_, int c_, int nwg_main) { const int rem = nwg_main % G_; cskip = rem; StaticOrder::init(M_, N_, G_ - rem, c_ - rem); }
    __host__ __device__ bool next(int i, Unit& u) const { if (c < 0) return false; return StaticOrder::next(i, u); } };
struct MapOrder : StaticOrder { int lo_n, gap;
    __host__ __device__ bool next(int i, Unit& u) const { if (!StaticOrder::next(i, u)) return false; if (u.pn >= lo_n) u.pn += gap; return true; } };
struct MaskOrder : StaticOrder { int mm, mn;
    __host__ __device__ bool next(int i, Unit& u) const { if (!StaticOrder::next(i, u)) return false; u.pm &= mm; u.pn &= mn; return true; } };
struct FixedOrder { int n;
    __host__ __device__ bool next(int i, Unit& u) const { if (i >= n) return false; u.pm = 0; u.pn = 0; return true; } };
template <class Epi, class Sched, bool TILED_UNUSED = false, int MODE = 0>
__device__ __forceinline__ void gemm_phase(LAS unsigned char* lds, const Gemm g, const Sched& S, const Epi& E, const int wid) {
    const int lane = lane_id(), tid = wid * 64 + lane;
    const int wr = wid >> 2, wc = wid & 3, fr = lane & 15, fq = lane >> 4;
    const int K = g.ld ? g.ld : g.K, nt = g.K / BK;
    unsigned voffA, voffB;
    { int R, C; stage_rc(tid * 16, R, C); const int Rb = (R & ~31) + perm32(R & 31); voffA = (unsigned)(R * K + C) * 2u; voffB = (unsigned)(Rb * K + C) * 2u; }
    const size_t pstep = (size_t)64 * K * 2;
    const size_t kstep = (size_t)(BK * 2);
    const size_t hstep = (size_t)HALF * K * 2;
    const size_t tstep = 2 * hstep;
    const unsigned ldsw = (unsigned)wid * 1024u;
    const int aoff = lds_byte(wr * 64 + fr, fq * 8), boff = lds_byte(wc * 32 + fr, fq * 8);
#define PG8_SA(b, h) (((b) * 2 + (h)) * HTB)
#define PG8_SB(b, h) ((4 + (b) * 2 + (h)) * HTB)
#define PG8_STAGE(bufoff, gbase, voff) do { _Pragma("unroll") for (int _i = 0; _i < 2; ++_i) \
        __builtin_amdgcn_global_load_lds((const unsigned*)((const char*)(gbase) + _i * pstep + (voff)), (LAS unsigned*)(lds + (bufoff) + ldsw + _i * 8192), 16, 0, 0); } while (0)
#define PG8_LDA(dst, b, h) do { _Pragma("unroll") for (int m = 0; m < 4; ++m) _Pragma("unroll") for (int k = 0; k < 2; ++k) dst[m][k] = *(const LAS bf16x8*)(lds + PG8_SA(b, h) + aoff + m * 2048 + k * 1024); } while (0)
#define PG8_LDB(dst, b, h) do { _Pragma("unroll") for (int n = 0; n < 2; ++n) _Pragma("unroll") for (int k = 0; k < 2; ++k) dst[n][k] = *(const LAS bf16x8*)(lds + PG8_SB(b, h) + boff + n * 2048 + k * 1024); } while (0)
#define F8_SCALE 0x3f800000
#define F8_OPSEL 2
#define PG8_CAT8(x) __builtin_shufflevector(__builtin_bit_cast(i32x4, (x)[0]), __builtin_bit_cast(i32x4, (x)[1]), 0, 1, 2, 3, 4, 5, 6, 7)
#define PG8_MMA(ai, bj, At, Bt) do { __builtin_amdgcn_s_setprio(1); _Pragma("unroll") for (int m = 0; m < 4; ++m) _Pragma("unroll") for (int n = 0; n < 2; ++n) { \
        if constexpr (MODE == 1) acc[ai][bj][m][n] = __builtin_amdgcn_mfma_scale_f32_16x16x128_f8f6f4(PG8_CAT8(Bt[n]), PG8_CAT8(At[m]), acc[ai][bj][m][n], 0, 0, F8_OPSEL, F8_SCALE, F8_OPSEL, F8_SCALE); \
        else if constexpr (MODE == 2) { _Pragma("unroll") for (int k = 0; k < 2; ++k) acc[ai][bj][m][n] = __builtin_bit_cast(f32x4, __builtin_amdgcn_mfma_i32_16x16x64_i8(__builtin_bit_cast(i32x4, Bt[n][k]), __builtin_bit_cast(i32x4, At[m][k]), __builtin_bit_cast(i32x4, acc[ai][bj][m][n]), 0, 0, 0)); } \
        else { _Pragma("unroll") for (int k = 0; k < 2; ++k) acc[ai][bj][m][n] = __builtin_amdgcn_mfma_f32_16x16x32_bf16(Bt[n][k], At[m][k], acc[ai][bj][m][n], 0, 0, 0); } } \
        __builtin_amdgcn_s_setprio(0); } while (0)
#define PG8_WAIT_V(n) asm volatile("s_waitcnt vmcnt(" #n ")" ::: "memory")
#define PG8_WAIT_L(n) asm volatile("s_waitcnt lgkmcnt(" #n ")" ::: "memory")
#define PG8_BAR __builtin_amdgcn_s_barrier()
#if ASYM_WAIT
#define PG8_WT do { if (wr == 1) PG8_WAIT_V(8); } while (0)
#define PG8_WL do { if (wr == 0) PG8_WAIT_V(8); } while (0)
#else
#define PG8_WT PG8_WAIT_V(8)
#define PG8_WL do { } while (0)
#endif
#define PG8_SCHED __builtin_amdgcn_sched_barrier(0)
    Unit cur, nxt; int ui = 0;
    if (!S.next(0, cur)) return;
    f32x4 acc[2][2][4][2];
#pragma unroll
    for (int a = 0; a < 2; ++a)
#pragma unroll
        for (int b = 0; b < 2; ++b)
#pragma unroll
            for (int m = 0; m < 4; ++m)
#pragma unroll
                for (int n = 0; n < 2; ++n) acc[a][b][m][n] = (f32x4){0.f, 0.f, 0.f, 0.f};
    bf16x8 At[4][2], B0[2][2], B1[2][2];
    const char* cA = (const char*)g.A + (size_t)cur.pm * tstep; const char* cB = (const char*)g.Bt + (size_t)cur.pn * tstep;
    PG8_STAGE(PG8_SB(0, 0), cB, voffB); PG8_STAGE(PG8_SB(0, 1), cB + hstep, voffB); PG8_STAGE(PG8_SA(0, 0), cA, voffA); PG8_STAGE(PG8_SA(0, 1), cA + hstep, voffA);
    if (wr == 1) PG8_BAR;
    PG8_WAIT_V(2); PG8_BAR;
    PG8_STAGE(PG8_SB(1, 0), cB + kstep, voffB); PG8_STAGE(PG8_SA(1, 0), cA + kstep, voffA); PG8_STAGE(PG8_SB(1, 1), cB + hstep + kstep, voffB);
    PG8_WAIT_V(6); PG8_BAR;
    for (;;) {
        const bool has_next = S.next(ui + 1, nxt);
        const char* nA = has_next ? (const char*)g.A + (size_t)nxt.pm * tstep : cA; const char* nB = has_next ? (const char*)g.Bt + (size_t)nxt.pn * tstep : cB;
        for (int t = 0; t < nt; t += 2) {
            const bool last = (t == nt - 2);
            const char* a1 = cA + (size_t)(t + 1) * kstep;
            const char* a2 = last ? nA : cA + (size_t)(t + 2) * kstep; const char* b2 = last ? nB : cB + (size_t)(t + 2) * kstep;
            const char* a3 = a2 + kstep; const char* b3 = b2 + kstep;
            PG8_LDB(B0, 0, 0); PG8_LDB(B1, 0, 1); PG8_SCHED; PG8_LDA(At, 0, 0); PG8_STAGE(PG8_SA(1, 1), a1 + hstep, voffA);
            PG8_WT; PG8_WAIT_L(0); PG8_BAR; PG8_MMA(0, 0, At, B0); PG8_MMA(0, 1, At, B1); PG8_WL; PG8_BAR; PG8_SCHED;
            PG8_LDA(At, 0, 1); PG8_STAGE(PG8_SB(0, 0), b2, voffB); PG8_STAGE(PG8_SB(0, 1), b2 + hstep, voffB); PG8_STAGE(PG8_SA(0, 0), a2, voffA);
            PG8_WT; PG8_WAIT_L(0); PG8_BAR; PG8_MMA(1, 0, At, B0); PG8_MMA(1, 1, At, B1); PG8_WL; PG8_BAR; PG8_SCHED;
            PG8_LDB(B0, 1, 0); PG8_LDB(B1, 1, 1); PG8_SCHED; PG8_LDA(At, 1, 0); PG8_STAGE(PG8_SA(0, 1), a2 + hstep, voffA);
            PG8_WT; PG8_WAIT_L(0); PG8_BAR; PG8_MMA(0, 0, At, B0); PG8_MMA(0, 1, At, B1); PG8_WL; PG8_BAR; PG8_SCHED;
            PG8_LDA(At, 1, 1); PG8_STAGE(PG8_SB(1, 0), b3, voffB); PG8_STAGE(PG8_SB(1, 1), b3 + hstep, voffB); PG8_STAGE(PG8_SA(1, 0), a3, voffA);
            PG8_WT; PG8_WAIT_L(0); PG8_BAR; PG8_MMA(1, 0, At, B0); PG8_MMA(1, 1, At, B1); PG8_WL; PG8_BAR; PG8_SCHED;
        }
        if (wr == 0) PG8_BAR;
        E(acc, cur, wr, wc, wid);
        if (!has_next) break;
#pragma unroll
        for (int a = 0; a < 2; ++a)
#pragma unroll
            for (int b = 0; b < 2; ++b)
#pragma unroll
                for (int m = 0; m < 4; ++m)
#pragma unroll
                    for (int n = 0; n < 2; ++n) acc[a][b][m][n] = (f32x4){0.f, 0.f, 0.f, 0.f};
        cur = nxt; cA = nA; cB = nB; ++ui;
        if (wr == 1) PG8_BAR;
    }
    PG8_WAIT_V(0);
    PG8_BAR;
#undef PG8_SA
#undef PG8_SB
#undef PG8_STAGE
#undef PG8_LDA
#undef PG8_LDB
#undef PG8_MMA
#undef PG8_CAT8
#undef PG8_WAIT_V
#undef PG8_WAIT_L
#undef PG8_BAR
#undef PG8_WT
#undef PG8_WL
#undef PG8_SCHED
}
}

typedef GAS unsigned gu32;
#define RLX_AGENT __ATOMIC_RELAXED, __HIP_MEMORY_SCOPE_AGENT
#define LDS_WAIT() asm volatile("s_waitcnt lgkmcnt(0)" ::: "memory")
#define VM_WAIT() asm volatile("s_waitcnt vmcnt(0)" ::: "memory")
__device__ __forceinline__ unsigned f2bf(float f) { unsigned u = __builtin_bit_cast(unsigned, f); return (u + 0x7fffu + ((u >> 16) & 1u)) >> 16; }
__device__ __forceinline__ unsigned pk2(float lo, float hi) { return f2bf(lo) | (f2bf(hi) << 16); }

#define XB_TMO      128
#define XB_XCNT(j)  (256  + 64 * (j))
#define XB_XSUB(j)  (1280 + 64 * (j))
#define XB_XGEN(j)  (2304 + 64 * (j))
#define XB_TOP      3328
#define XB_TOPGEN   3392
#define XCD_BAR_WORDS 3456
#define XB_SPIN_CAP (1u << 18)
__device__ __forceinline__ unsigned xb_ld(unsigned* p)              { return __hip_atomic_load(p, __ATOMIC_RELAXED, __HIP_MEMORY_SCOPE_AGENT); }
__device__ __forceinline__ unsigned xb_add(unsigned* p, unsigned v) { return __hip_atomic_fetch_add(p, v, __ATOMIC_RELAXED, __HIP_MEMORY_SCOPE_AGENT); }
__device__ __forceinline__ unsigned xb_xcc_id() { return (unsigned)__builtin_amdgcn_s_getreg((3 << 11) | 20) & 0xFu; }
#define XB_SPIN(cond, bar) do { unsigned _sp = 0; while (cond) { __builtin_amdgcn_s_sleep(1); \
    if ((++_sp & 255u) == 0u) { if (xb_ld(&(bar)[XB_TMO])) break; if (_sp > XB_SPIN_CAP) { atomicAdd(&(bar)[XB_TMO], 1u); break; } } } } while (0)
struct XcdBarrier { unsigned* bar; unsigned x; volatile LAS unsigned* st; };
__device__ __forceinline__ XcdBarrier xcd_barrier_post(unsigned* bar, volatile LAS unsigned* st) {
    XcdBarrier b; b.bar = bar; b.x = xb_xcc_id(); b.st = st;
    if (threadIdx.x == 0) (void)xb_add(&bar[XB_XCNT(b.x)], 1u);
    return b;
}
__device__ __forceinline__ void xcd_barrier_complete(unsigned* bar, unsigned x, unsigned& nloc, unsigned& nx) {
    const unsigned G = gridDim.x * gridDim.y * gridDim.z;
    unsigned sum, cnt, mine, sp = 0u;
    for (;;) {
        sum = 0u; cnt = 0u; mine = 0u;
#pragma unroll
        for (unsigned j = 0; j < 16; ++j) { const unsigned c = xb_ld(&bar[XB_XCNT(j)]); sum += c; cnt += (c > 0u) ? 1u : 0u; mine = (j == x) ? c : mine; }
        if (sum == G) break;
        __builtin_amdgcn_s_sleep(1);
        if ((++sp & 255u) == 0u) { if (xb_ld(&bar[XB_TMO])) break; if (sp > XB_SPIN_CAP) { atomicAdd(&bar[XB_TMO], 1u); break; } }
    }
    nloc = mine > 0u ? mine : 1u; nx = cnt > 0u ? cnt : 1u;
}
__device__ __forceinline__ void xcd_barrier(const XcdBarrier& b) {
    asm volatile("s_waitcnt vmcnt(0)" ::: "memory");
    __syncthreads();
    if (threadIdx.x == 0) {
        unsigned* bar = b.bar;
        __builtin_amdgcn_s_waitcnt(0);
        unsigned nloc = b.st[0], nx = b.st[1];
        if (nloc == 0u) { xcd_barrier_complete(bar, b.x, nloc, nx); b.st[0] = nloc; b.st[1] = nx; }
        const unsigned old = xb_add(&bar[XB_XSUB(b.x)], 1u);
        const unsigned gen = old / nloc;
        if (old + 1u == (gen + 1u) * nloc) {
            __builtin_amdgcn_fence(__ATOMIC_RELEASE, "agent");
            asm volatile("s_waitcnt vmcnt(0)" ::: "memory");
            const unsigned og = xb_add(&bar[XB_TOP], 1u);
            const unsigned tg = og / nx;
            if (og + 1u == (tg + 1u) * nx) xb_add(&bar[XB_TOPGEN], 1u);
            else XB_SPIN(xb_ld(&bar[XB_TOPGEN]) == tg, bar);
            __builtin_amdgcn_fence(__ATOMIC_ACQUIRE, "agent");
            xb_add(&bar[XB_XGEN(b.x)], 1u);
            asm volatile("s_waitcnt vmcnt(0)" ::: "memory");
        } else {
            XB_SPIN(xb_ld(&bar[XB_XGEN(b.x)]) == gen, bar);
            __builtin_amdgcn_fence(__ATOMIC_ACQUIRE, "agent");
            asm volatile("s_waitcnt vmcnt(0)" ::: "memory");
        }
    }
    __syncthreads();
}

__device__ __forceinline__ float wave_sum(float v) {
#pragma unroll
    for (int o = 1; o < 64; o <<= 1) v += __shfl_xor(v, o);
    return v;
}
__device__ __forceinline__ void p0_transpose_item(const float* W, int K, int N, bf16_t* WT, int out_row0, const float* g, LAS float* scr, int k0, int n0, int lane) {
    float v[32];
    const float* src = W + (size_t)(k0 + (lane >> 5)) * N + n0 + (lane & 31);
#pragma unroll
    for (int i = 0; i < 32; ++i) v[i] = src[(size_t)(2 * i) * N];
#pragma unroll
    for (int i = 0; i < 32; ++i) scr[(2 * i + (lane >> 5)) * 33 + (lane & 31)] = v[i];
    LDS_WAIT(); asm volatile("" ::: "memory");
    const int c = lane & 7;
    f32x4 ga = {1.f, 1.f, 1.f, 1.f}, gb = {1.f, 1.f, 1.f, 1.f};
    if (g) { ga = *(const f32x4*)(g + k0 + 8 * c); gb = *(const f32x4*)(g + k0 + 8 * c + 4); }
#pragma unroll
    for (int j = 0; j < 4; ++j) { const int n = (lane >> 3) + 8 * j; const LAS float* s = scr + (8 * c) * 33 + n;
        u32x4 o; o.x = pk2(s[0 * 33] * ga[0], s[1 * 33] * ga[1]); o.y = pk2(s[2 * 33] * ga[2], s[3 * 33] * ga[3]); o.z = pk2(s[4 * 33] * gb[0], s[5 * 33] * gb[1]); o.w = pk2(s[6 * 33] * gb[2], s[7 * 33] * gb[3]);
        *(GAS u32x4*)(WT + (size_t)(out_row0 + n) * K + k0 + 8 * c) = o; }
    LDS_WAIT(); asm volatile("" ::: "memory");
}
__device__ __forceinline__ void p0_transpose_item_fp8(const float* W, int K, int N, unsigned char* WT8, int out_row0, const float* g, float scale, LAS float* scr, int k0, int n0, int lane) {
    float v[32];
    const float* src = W + (size_t)(k0 + (lane >> 5)) * N + n0 + (lane & 31);
#pragma unroll
    for (int i = 0; i < 32; ++i) v[i] = src[(size_t)(2 * i) * N];
#pragma unroll
    for (int i = 0; i < 32; ++i) scr[(2 * i + (lane >> 5)) * 33 + (lane & 31)] = v[i];
    LDS_WAIT(); asm volatile("" ::: "memory");
    const int c = lane & 7;
    const f32x4 ga = *(const f32x4*)(g + k0 + 8 * c) * scale, gb = *(const f32x4*)(g + k0 + 8 * c + 4) * scale;
#pragma unroll
    for (int j = 0; j < 4; ++j) { const int n = (lane >> 3) + 8 * j; const LAS float* s = scr + (8 * c) * 33 + n;
        u32x2 o; o.x = pg8::pk4_fp8(s[0 * 33] * ga[0], s[1 * 33] * ga[1], s[2 * 33] * ga[2], s[3 * 33] * ga[3]); o.y = pg8::pk4_fp8(s[4 * 33] * gb[0], s[5 * 33] * gb[1], s[6 * 33] * gb[2], s[7 * 33] * gb[3]);
        *(GAS u32x2*)(WT8 + (size_t)(out_row0 + n) * K + k0 + 8 * c) = o; }
    LDS_WAIT(); asm volatile("" ::: "memory");
}
__device__ __forceinline__ void p0_transpose_item_i8(const float* W, int K, int N, unsigned char* WT8, int out_row0, const float* g, const unsigned* cmax, LAS float* scr, int k0, int n0, int lane) {
    float v[32];
    const float* src = W + (size_t)(k0 + (lane >> 5)) * N + n0 + (lane & 31);
    const int c = lane & 7;
    float cmv[4];
#pragma unroll
    for (int j = 0; j < 4; ++j) cmv[j] = __uint_as_float(cmax[n0 + (lane >> 3) + 8 * j]);
    f32x4 ga = {1.f, 1.f, 1.f, 1.f}, gb = {1.f, 1.f, 1.f, 1.f};
    if (g) { ga = *(const f32x4*)(g + k0 + 8 * c); gb = *(const f32x4*)(g + k0 + 8 * c + 4); }
#pragma unroll
    for (int i = 0; i < 32; ++i) v[i] = src[(size_t)(2 * i) * N];
#pragma unroll
    for (int i = 0; i < 32; ++i) scr[(2 * i + (lane >> 5)) * 33 + (lane & 31)] = v[i];
    LDS_WAIT(); asm volatile("" ::: "memory");
#pragma unroll
    for (int j = 0; j < 4; ++j) { const int n = (lane >> 3) + 8 * j; const LAS float* s = scr + (8 * c) * 33 + n;
        const float cm = cmv[j], inv = cm > 0.f ? 127.0f / cm : 0.f;
        u32x2 o; o.x = pg8::pk4_i8((f32x4){s[0 * 33] * ga[0], s[1 * 33] * ga[1], s[2 * 33] * ga[2], s[3 * 33] * ga[3]} * inv); o.y = pg8::pk4_i8((f32x4){s[4 * 33] * gb[0], s[5 * 33] * gb[1], s[6 * 33] * gb[2], s[7 * 33] * gb[3]} * inv);
        *(GAS u32x2*)(WT8 + (size_t)(out_row0 + n) * K + k0 + 8 * c) = o; }
    LDS_WAIT(); asm volatile("" ::: "memory");
}
__device__ __forceinline__ float wave_max(float v) {
#pragma unroll
    for (int o = 1; o < 64; o <<= 1) v = fmaxf(v, __shfl_xor(v, o));
    return v;
}
template <bool HASG>
__device__ __forceinline__ void colmax_item(const float* W, int N, int n_lo, int nb512, const float* g, unsigned* CM, int ci, int wave, int lane, LAS float* scr) {
    {
        const int kb8 = ci / nb512, nb = ci - kb8 * nb512, k0 = 256 * kb8 + 32 * wave;
        const float* src = W + (size_t)k0 * N + n_lo + 512 * nb + 4 * lane;
        float gk = 1.0f; if (HASG) gk = fabsf(g[k0 + (lane & 31)]);
        f32x4 mx0 = {0.f, 0.f, 0.f, 0.f}, mx1 = {0.f, 0.f, 0.f, 0.f};
#pragma unroll
        for (int h = 0; h < 2; ++h) {
            f32x4 v[16][2];
#pragma unroll
            for (int i = 0; i < 16; ++i) { v[i][0] = *(const f32x4*)(src + (size_t)(16 * h + i) * N); v[i][1] = *(const f32x4*)(src + (size_t)(16 * h + i) * N + 256); }
#pragma unroll
            for (int i = 0; i < 16; ++i) { f32x4 a0 = __builtin_elementwise_abs(v[i][0]), a1 = __builtin_elementwise_abs(v[i][1]);
                if (HASG) { const float gi = __builtin_bit_cast(float, __builtin_amdgcn_readlane(__builtin_bit_cast(int, gk), 16 * h + i)); a0 = a0 * gi; a1 = a1 * gi; }
                mx0 = __builtin_elementwise_max(mx0, a0); mx1 = __builtin_elementwise_max(mx1, a1); }
        }
        *(LAS f32x4*)&scr[wave * 512 + 4 * lane] = mx0; *(LAS f32x4*)&scr[wave * 512 + 256 + 4 * lane] = mx1;
        __syncthreads();
        { const int t = wave * 64 + lane; float m = scr[t];
#pragma unroll
          for (int w = 1; w < 8; ++w) m = fmaxf(m, scr[w * 512 + t]);
          (void)__hip_atomic_fetch_max(CM + n_lo + 512 * nb + t, __float_as_uint(m), __ATOMIC_RELAXED, __HIP_MEMORY_SCOPE_AGENT); }
        __syncthreads();
    }
}
__device__ __forceinline__ void p0_load_tile(const float* W, int N, int k0, int n0, int lane, float (&v)[32]) {
    const float* src = W + (size_t)(k0 + (lane >> 5)) * N + n0 + (lane & 31);
#pragma unroll
    for (int i = 0; i < 32; ++i) v[i] = src[(size_t)(2 * i) * N];
}
__device__ __forceinline__ void p0_finish_bf16(const float (&v)[32], int K, bf16_t* WT, int out_row0, const float* g, LAS float* scr, int k0, int lane) {
#pragma unroll
    for (int i = 0; i < 32; ++i) scr[(2 * i + (lane >> 5)) * 33 + (lane & 31)] = v[i];
    LDS_WAIT(); asm volatile("" ::: "memory");
    const int c = lane & 7;
    f32x4 ga = {1.f, 1.f, 1.f, 1.f}, gb = {1.f, 1.f, 1.f, 1.f};
    if (g) { ga = *(const f32x4*)(g + k0 + 8 * c); gb = *(const f32x4*)(g + k0 + 8 * c + 4); }
#pragma unroll
    for (int j = 0; j < 4; ++j) { const int n = (lane >> 3) + 8 * j; const LAS float* s = scr + (8 * c) * 33 + n;
        u32x4 o; o.x = pk2(s[0 * 33] * ga[0], s[1 * 33] * ga[1]); o.y = pk2(s[2 * 33] * ga[2], s[3 * 33] * ga[3]); o.z = pk2(s[4 * 33] * gb[0], s[5 * 33] * gb[1]); o.w = pk2(s[6 * 33] * gb[2], s[7 * 33] * gb[3]);
        *(GAS u32x4*)(WT + (size_t)(out_row0 + n) * K + k0 + 8 * c) = o; }
    LDS_WAIT(); asm volatile("" ::: "memory");
}
__device__ __forceinline__ void p0_finish_i8(const float (&v)[32], int K, unsigned char* WT8, int out_row0, const float* g, const unsigned* cmax, int n0, LAS float* scr, int k0, int lane) {
    const int c = lane & 7;
    float cmv[4];
#pragma unroll
    for (int j = 0; j < 4; ++j) cmv[j] = __uint_as_float(cmax[n0 + (lane >> 3) + 8 * j]);
    f32x4 ga = {1.f, 1.f, 1.f, 1.f}, gb = {1.f, 1.f, 1.f, 1.f};
    if (g) { ga = *(const f32x4*)(g + k0 + 8 * c); gb = *(const f32x4*)(g + k0 + 8 * c + 4); }
#pragma unroll
    for (int i = 0; i < 32; ++i) scr[(2 * i + (lane >> 5)) * 33 + (lane & 31)] = v[i];
    LDS_WAIT(); asm volatile("" ::: "memory");
#pragma unroll
    for (int j = 0; j < 4; ++j) { const int n = (lane >> 3) + 8 * j; const LAS float* s = scr + (8 * c) * 33 + n;
        const float cm = cmv[j], inv = cm > 0.f ? 127.0f / cm : 0.f;
        u32x2 o; o.x = pg8::pk4_i8((f32x4){s[0 * 33] * ga[0], s[1 * 33] * ga[1], s[2 * 33] * ga[2], s[3 * 33] * ga[3]} * inv); o.y = pg8::pk4_i8((f32x4){s[4 * 33] * gb[0], s[5 * 33] * gb[1], s[6 * 33] * gb[2], s[7 * 33] * gb[3]} * inv);
        *(GAS u32x2*)(WT8 + (size_t)(out_row0 + n) * K + k0 + 8 * c) = o; }
    LDS_WAIT(); asm volatile("" ::: "memory");
}
template <class Fin>
__device__ __forceinline__ void p0_pipe(const float* W, int N, int nblk, int nitems, int gw, int NGW, int lane, const Fin& fin) {
    float va[32], vb[32];
#pragma unroll
    for (int i = 0; i < 32; ++i) vb[i] = 0.f;
    int it = gw;
    if (it < nitems) { const int kb = it / nblk, nb = it - kb * nblk; p0_load_tile(W, N, 64 * kb, 32 * nb, lane, va); }
    for (; it < nitems; it += NGW) {
        const int nx = it + NGW;
        if (nx < nitems) { const int kb = nx / nblk, nb = nx - kb * nblk; p0_load_tile(W, N, 64 * kb, 32 * nb, lane, vb); }
        { const int kb = it / nblk, nb = it - kb * nblk; fin(va, 64 * kb, 32 * nb); }
#pragma unroll
        for (int i = 0; i < 32; ++i) va[i] = vb[i];
    }
}
__device__ __forceinline__ void p0_matrix(const float* W, int K, int N, bf16_t* WT, const float* g, bool upmap, LAS float* scr, int gw, int NGW, int lane) {
    const int nblk = N / 32, nitems = (K / 64) * nblk;
    for (int it = gw; it < nitems; it += NGW) {
        const int kb = it / nblk, nb = it - kb * nblk, n0 = 32 * nb;
        int orow = n0;
        if (upmap) orow = (n0 < DFF) ? 256 * (n0 >> 7) + (n0 & 127) : 256 * ((n0 - DFF) >> 7) + 128 + ((n0 - DFF) & 127);
        p0_transpose_item(W, K, N, WT, orow, g, scr, 64 * kb, n0, lane);
    }
}

__device__ __forceinline__ void row_to_i8(const bf16_t* X, unsigned char* A8, float* RS, int m, int lane) {
    const u32x4* src = (const u32x4*)(X + (size_t)m * DM) + lane;
    u32x4 w[8]; float mx = 0.f, ss = 0.f;
#pragma unroll
    for (int j = 0; j < 8; ++j) w[j] = src[64 * j];
#pragma unroll
    for (int j = 0; j < 8; ++j) { f32x4 a, b; pg8::bf8_to_f32(w[j], a, b); ss += pg8::sumsq4(a) + pg8::sumsq4(b);
        const f32x4 ab = __builtin_elementwise_max(__builtin_elementwise_abs(a), __builtin_elementwise_abs(b)); mx = fmaxf(mx, fmaxf(fmaxf(ab[0], ab[1]), fmaxf(ab[2], ab[3]))); }
    mx = wave_max(mx); ss = wave_sum(ss);
    const float inv = mx > 0.f ? 127.0f / mx : 0.f;
    u32x2* dst = (u32x2*)(A8 + (size_t)m * DM) + lane;
#pragma unroll
    for (int j = 0; j < 8; ++j) { f32x4 a, b; pg8::bf8_to_f32(w[j], a, b); u32x2 o; o.x = pg8::pk4_i8(a * inv); o.y = pg8::pk4_i8(b * inv); dst[64 * j] = o; }
    if (lane == 0) RS[m] = rsqrtf(ss * (1.0f / DM) + EPS) * mx * (1.0f / 127.0f);
}

__device__ __forceinline__ unsigned offb(unsigned row, unsigned ch) { return 256u * row + 16u * (ch ^ (((row & 3u) << 2) | ((row >> 2) & 3u))); }
__device__ __forceinline__ s16x4 vtr(const LAS unsigned char* p) { return __builtin_bit_cast(s16x4, __builtin_amdgcn_ds_read_tr16_b64_v4i16((LAS s16x4*)p)); }
#define MFMA16(a, b, c) __builtin_amdgcn_mfma_f32_16x16x32_bf16(a, b, c, 0, 0, 0)
__device__ __forceinline__ void lds_read8_b128(bf16x8 (&k)[8], const unsigned (&a)[8]) {
    asm volatile("ds_read_b128 %0, %8\n\tds_read_b128 %1, %9\n\tds_read_b128 %2, %10\n\tds_read_b128 %3, %11\n\tds_read_b128 %4, %12\n\tds_read_b128 %5, %13\n\tds_read_b128 %6, %14\n\tds_read_b128 %7, %15\n\ts_waitcnt lgkmcnt(0)"
                 : "=&v"(k[0]), "=&v"(k[1]), "=&v"(k[2]), "=&v"(k[3]), "=&v"(k[4]), "=&v"(k[5]), "=&v"(k[6]), "=&v"(k[7])
                 : "v"(a[0]), "v"(a[1]), "v"(a[2]), "v"(a[3]), "v"(a[4]), "v"(a[5]), "v"(a[6]), "v"(a[7]) : "memory");
}
__device__ __forceinline__ void lds_read8_tr(s16x4 (&v)[8], const unsigned (&a)[8]) {
    asm volatile("ds_read_b64_tr_b16 %0, %8\n\tds_read_b64_tr_b16 %1, %9\n\tds_read_b64_tr_b16 %2, %10\n\tds_read_b64_tr_b16 %3, %11\n\tds_read_b64_tr_b16 %4, %12\n\tds_read_b64_tr_b16 %5, %13\n\tds_read_b64_tr_b16 %6, %14\n\tds_read_b64_tr_b16 %7, %15\n\ts_waitcnt lgkmcnt(0)"
                 : "=&v"(v[0]), "=&v"(v[1]), "=&v"(v[2]), "=&v"(v[3]), "=&v"(v[4]), "=&v"(v[5]), "=&v"(v[6]), "=&v"(v[7])
                 : "v"(a[0]), "v"(a[1]), "v"(a[2]), "v"(a[3]), "v"(a[4]), "v"(a[5]), "v"(a[6]), "v"(a[7]) : "memory");
}

__device__ __forceinline__ void gate_phase(LAS unsigned char* lds, const bf16_t* U, const bf16_t* VSN, const bf16_t* WS, const float* bs, const float* ga, bf16_t* mix, int vcu, int G, const int w) {
    const int lane = lane_id(), tid = w * 64 + lane, i16 = lane & 15, g = lane >> 4, q = i16 >> 2, p = i16 & 3;
    unsigned ldsw[4], goff[4];
#pragma unroll
    for (int i = 0; i < 4; ++i) { const int c = tid + 512 * i, tok = c >> 4, ch = c & 15; ldsw[i] = offb(tok, ch); goff[i] = tok * DG + ch * 8; }
    unsigned va[2][8];
#pragma unroll
    for (int t = 0; t < 2; ++t)
#pragma unroll
        for (int c = 0; c < 8; ++c) va[t][c] = offb(8 * g + 4 * t + q, 2 * c + (p >> 1)) + 8 * (p & 1);
    const int NU = 128 * 16;
    u32x4 st[4];
    int it = vcu;
    if (it < NU) {
        const bf16_t* src = VSN + (size_t)((it >> 4) * 128) * DG + (it & 15) * HD;
#pragma unroll
        for (int i = 0; i < 4; ++i) st[i] = *(const u32x4*)(src + goff[i]);
    }
    int par = 0;
    for (; it < NU; it += G, par ^= 1) {
        const int cidx = it >> 4, h = it & 15;
        LAS unsigned char* buf = lds + par * 32768;
#pragma unroll
        for (int i = 0; i < 4; ++i) *(LAS u32x4*)(buf + ldsw[i]) = st[i];
        LDS_WAIT(); __builtin_amdgcn_s_barrier(); asm volatile("" ::: "memory");
        const int nit = it + G;
        if (nit < NU) {
            const bf16_t* src = VSN + (size_t)((nit >> 4) * 128) * DG + (nit & 15) * HD;
#pragma unroll
            for (int i = 0; i < 4; ++i) st[i] = *(const u32x4*)(src + goff[i]);
        }
        bf16x8 wf[4];
        const bf16_t* wsp = WS + ((size_t)h * 128 + 16 * w + i16) * 128 + 8 * g;
#pragma unroll
        for (int ks = 0; ks < 4; ++ks) wf[ks] = *(const bf16x8*)(wsp + 32 * ks);
        f32x4 acc[8];
#pragma unroll
        for (int c = 0; c < 8; ++c) acc[c] = (f32x4){0.f, 0.f, 0.f, 0.f};
#pragma unroll
        for (int ks = 0; ks < 4; ++ks)
#pragma unroll
            for (int c = 0; c < 8; ++c) {
                const s16x4 lo = vtr(buf + va[0][c] + ks * 8192), hi = vtr(buf + va[1][c] + ks * 8192);
                const bf16x8 vf = {lo[0], lo[1], lo[2], lo[3], hi[0], hi[1], hi[2], hi[3]};
                acc[c] = MFMA16(vf, wf[ks], acc[c]);
            }
        const int tok = cidx * 128 + 16 * w + i16;
        const float bias = bs[h * 128 + 16 * w + i16];
        const bf16_t* up = U + (size_t)tok * DG + h * HD + 4 * g;
        float ss = 0.f;
#pragma unroll
        for (int c = 0; c < 8; ++c) {
            const u32x2 uw = *(const u32x2*)(up + 16 * c);
            f32x4 uv; uv[0] = __uint_as_float(uw.x << 16); uv[1] = __uint_as_float(uw.x & 0xffff0000u); uv[2] = __uint_as_float(uw.y << 16); uv[3] = __uint_as_float(uw.y & 0xffff0000u);
            acc[c] = uv * (acc[c] + bias); ss += pg8::sumsq4(acc[c]);
        }
        ss = pg8::xsum_fq(ss);
        const float rr = rsqrtf(ss * (1.0f / 128.0f) + EPS);
        bf16_t* op = mix + (size_t)tok * DM + h * HD + 4 * g;
        const float* gp = ga + h * HD + 4 * g;
        f32x4 gvv[8];
#pragma unroll
        for (int c = 0; c < 8; ++c) gvv[c] = *(const f32x4*)(gp + 16 * c);
#pragma unroll
        for (int k2 = 0; k2 < 4; ++k2) {
            const f32x4 y0 = acc[2 * k2] * rr * gvv[2 * k2], y1 = acc[2 * k2 + 1] * rr * gvv[2 * k2 + 1];
            const u32x2 s0 = __builtin_amdgcn_permlane16_swap(pg8::cvt_pk_bf16(y0[0], y0[1]), pg8::cvt_pk_bf16(y1[0], y1[1]), false, false);
            const u32x2 s1 = __builtin_amdgcn_permlane16_swap(pg8::cvt_pk_bf16(y0[2], y0[3]), pg8::cvt_pk_bf16(y1[2], y1[3]), false, false);
            u32x4 o; o.x = s0.x; o.y = s1.x; o.z = s0.y; o.w = s1.y;
            *(u32x4*)(op - 4 * g + 16 * (2 * k2 + (g & 1)) + 4 * (g & 2)) = o;
        }
    }
    LDS_WAIT(); __builtin_amdgcn_s_barrier(); asm volatile("" ::: "memory");
}

__device__ __forceinline__ void na_phase(LAS unsigned char* lds, LAS float* rpbL, const bf16_t* Q, const bf16_t* Kt, const bf16_t* Vt, const float* rpb, const float* gb, bf16_t* mix, int vcu, int G, const int w) {
    const int lane = lane_id(), tid = w * 64 + lane, hh = w >> 2, cb = w & 3, i16 = lane & 15, g = lane >> 4, q = i16 >> 2, p = i16 & 3;
    const int kb = (16 * cb - 8) < 0 ? 0 : ((16 * cb - 8) > 32 ? 32 : (16 * cb - 8));
    unsigned goff[4];
#pragma unroll
    for (int i = 0; i < 4; ++i) { const unsigned o = (unsigned)((w * 4 + i) * 1024 + lane * 16), hd = o >> 14, o2 = o & 16383u, row = o2 >> 8, sp = (o2 >> 4) & 15u;
        const unsigned ch = sp ^ (((row & 3u) << 2) | ((row >> 2) & 3u)); goff[i] = row * DG + hd * 128 + ch * 8; }
    unsigned ka[2][4], va[2][8];
#pragma unroll
    for (int t = 0; t < 2; ++t) {
#pragma unroll
        for (int s = 0; s < 4; ++s) ka[t][s] = hh * 16384 + offb(kb + 8 * q + 4 * t + p, 4 * s + g);
#pragma unroll
        for (int c = 0; c < 8; ++c) va[t][c] = hh * 16384 + offb(kb + 8 * g + 4 * t + q, 2 * c + (p >> 1)) + 8 * (p & 1);
    }
    const int qc = 16 * cb + i16, cs = (qc - 8) < 0 ? 0 : ((qc - 8) > 48 ? 48 : (qc - 8));
    bool valid[2][4];
#pragma unroll
    for (int t = 0; t < 2; ++t)
#pragma unroll
        for (int e = 0; e < 4; ++e) { const int kc = kb + 8 * g + 4 * t + e; valid[t][e] = (kc >= cs) && (kc < cs + 16); }
    const int NI = 2 * 128 * 8;
    const float SC = 0.08838834764831845f * LOG2E;
#define NA_ISSUE(slot, src) do { _Pragma("unroll") for (int _i = 0; _i < 4; ++_i) \
        __builtin_amdgcn_global_load_lds((const unsigned*)((src) + goff[_i]), (LAS unsigned*)(lds + (slot) * 32768 + (w * 4 + _i) * 1024), 16, 0, 0); } while (0)
    int it = vcu;
    if (it < NI) {
        const int b = it >> 10, r = (it >> 3) & 127, hp = it & 7, rs = (r - 4) < 0 ? 0 : ((r - 4) > 120 ? 120 : (r - 4));
        const bf16_t* src = Kt + (size_t)(b * SEQ + rs * 64) * DG + hp * 256;
        NA_ISSUE(0, src); NA_ISSUE(1, src + (size_t)64 * DG); NA_ISSUE(2, src + (size_t)128 * DG);
    }
    int rpb_hp = -1;
    for (; it < NI; it += G) {
        const int b = it >> 10, r = (it >> 3) & 127, hp = it & 7, rs = (r - 4) < 0 ? 0 : ((r - 4) > 120 ? 120 : (r - 4));
        const int head = 2 * hp + hh;
        if (hp != rpb_hp) {
            for (int e = tid; e < 2 * 720; e += 512) { const int hd = e / 720, rem = e - hd * 720, dr = rem / 48, x = rem - dr * 48, dc = x - 8;
                rpbL[e] = (dc >= 0 && dc < 31) ? rpb[((2 * hp + hd) * 15 + dr) * 31 + dc] * LOG2E : 0.f; }
            if (tid < 256) rpbL[1440 + tid] = gb[(2 * hp) * HD + tid];
            rpb_hp = hp;
        }
        const size_t tq = (size_t)b * SEQ + r * 64 + qc;
        bf16x8 qf[4];
        { const bf16_t* qp = Q + tq * DG + head * HD + 8 * g;
#pragma unroll
          for (int s = 0; s < 4; ++s) qf[s] = *(const bf16x8*)(qp + 32 * s); }
        const bf16_t* kbase = Kt + (size_t)(b * SEQ + rs * 64) * DG + hp * 256;
        const bf16_t* vbase = Vt + (size_t)(b * SEQ + rs * 64) * DG + hp * 256;
        const int nit = it + G;
        const bf16_t* nsrc = kbase;
        if (nit < NI) { const int nb = nit >> 10, nr = (nit >> 3) & 127, nhp = nit & 7, nrs = (nr - 4) < 0 ? 0 : ((nr - 4) > 120 ? 120 : (nr - 4));
            nsrc = Kt + (size_t)(nb * SEQ + nrs * 64) * DG + nhp * 256; }
        f32x4 S[8][2];
        f32x4 O[8];
        bf16x8 pf[8];
        float inv_l = 0.f;
#pragma unroll
        for (int c = 0; c < 8; ++c) O[c] = (f32x4){0.f, 0.f, 0.f, 0.f};
#pragma unroll
        for (int sg = 0; sg < 16; ++sg) {
            LAS unsigned char* buf = lds + (sg & 3) * 32768;
            asm volatile("s_waitcnt vmcnt(8)" ::: "memory"); __builtin_amdgcn_s_barrier(); asm volatile("" ::: "memory");
            {
                const int t3 = sg + 3;
                const bf16_t* src = (t3 < 8) ? kbase + (size_t)(t3 * 64) * DG : ((t3 < 16) ? vbase + (size_t)((t3 - 8) * 64) * DG : nsrc + (size_t)((t3 - 16) * 64) * DG);
                NA_ISSUE(t3 & 3, src);
            }
            const unsigned sb = (unsigned)(size_t)buf;
            if (sg < 8) {
                bf16x8 kf[8]; unsigned ad[8];
#pragma unroll
                for (int t = 0; t < 2; ++t)
#pragma unroll
                    for (int s = 0; s < 4; ++s) ad[t * 4 + s] = sb + ka[t][s];
                lds_read8_b128(kf, ad);
#pragma unroll
                for (int t = 0; t < 2; ++t) {
                    f32x4 a = {0.f, 0.f, 0.f, 0.f};
#pragma unroll
                    for (int s = 0; s < 4; ++s) a = MFMA16(kf[t * 4 + s], qf[s], a);
                    S[sg & 7][t] = a;
                }
                if (sg == 7) {
                    const int rb = hh * 720 + (rs - r + 7) * 48 + (kb + 8 * g - qc + 23);
                    float mx = -3.0e38f;
#pragma unroll
                    for (int i = 0; i < 8; ++i)
#pragma unroll
                        for (int t = 0; t < 2; ++t)
#pragma unroll
                            for (int e = 0; e < 4; ++e) {
                                const float sv = valid[t][e] ? (S[i][t][e] * SC + rpbL[rb + i * 48 + 4 * t + e]) : -3.0e38f;
                                S[i][t][e] = sv; mx = fmaxf(mx, sv);
                            }
                    mx = fmaxf(mx, __shfl_xor(mx, 16)); mx = fmaxf(mx, __shfl_xor(mx, 32));
                    float l = 0.f;
#pragma unroll
                    for (int i = 0; i < 8; ++i) {
#pragma unroll
                        for (int t = 0; t < 2; ++t)
#pragma unroll
                            for (int e = 0; e < 4; ++e) { const float pe = __builtin_amdgcn_exp2f(S[i][t][e] - mx); S[i][t][e] = pe; l += pe; }
                        u32x4 pw; pw.x = pg8::cvt_pk_bf16(S[i][0][0], S[i][0][1]); pw.y = pg8::cvt_pk_bf16(S[i][0][2], S[i][0][3]);
                        pw.z = pg8::cvt_pk_bf16(S[i][1][0], S[i][1][1]); pw.w = pg8::cvt_pk_bf16(S[i][1][2], S[i][1][3]);
                        pf[i] = __builtin_bit_cast(bf16x8, pw);
                    }
                    l = pg8::xsum_fq(l);
                    inv_l = 1.0f / l;
                }
            } else {
#pragma unroll
                for (int hc = 0; hc < 2; ++hc) {
                    s16x4 lo[8], hi[8]; unsigned ad[8];
#pragma unroll
                    for (int c = 0; c < 4; ++c) { ad[c] = sb + va[0][hc * 4 + c]; ad[4 + c] = sb + va[1][hc * 4 + c]; }
                    { s16x4 tv[8]; lds_read8_tr(tv, ad);
#pragma unroll
                      for (int c = 0; c < 4; ++c) { lo[c] = tv[c]; hi[c] = tv[4 + c]; } }
#pragma unroll
                    for (int c = 0; c < 4; ++c) {
                        const bf16x8 vf = {lo[c][0], lo[c][1], lo[c][2], lo[c][3], hi[c][0], hi[c][1], hi[c][2], hi[c][3]};
                        O[hc * 4 + c] = MFMA16(vf, pf[sg & 7], O[hc * 4 + c]);
                    }
                }
            }
        }
        float ss = 0.f;
#pragma unroll
        for (int c = 0; c < 8; ++c) { O[c] = O[c] * inv_l; ss += pg8::sumsq4(O[c]); }
        ss = pg8::xsum_fq(ss);
        const float rr = rsqrtf(ss * (1.0f / 128.0f) + EPS);
        bf16_t* op = mix + tq * DM + DG + head * HD + 4 * g;
        const LAS float* gp = rpbL + 1440 + hh * HD + 4 * g;
        f32x4 gvv[8];
#pragma unroll
        for (int c = 0; c < 8; ++c) gvv[c] = *(const LAS f32x4*)(gp + 16 * c);
#pragma unroll
        for (int k2 = 0; k2 < 4; ++k2) {
            const f32x4 y0 = O[2 * k2] * rr * gvv[2 * k2], y1 = O[2 * k2 + 1] * rr * gvv[2 * k2 + 1];
            const u32x2 s0 = __builtin_amdgcn_permlane16_swap(pg8::cvt_pk_bf16(y0[0], y0[1]), pg8::cvt_pk_bf16(y1[0], y1[1]), false, false);
            const u32x2 s1 = __builtin_amdgcn_permlane16_swap(pg8::cvt_pk_bf16(y0[2], y0[3]), pg8::cvt_pk_bf16(y1[2], y1[3]), false, false);
            u32x4 o; o.x = s0.x; o.y = s1.x; o.z = s0.y; o.w = s1.y;
            *(u32x4*)(op - 4 * g + 16 * (2 * k2 + (g & 1)) + 4 * (g & 2)) = o;
        }
    }
#undef NA_ISSUE
    asm volatile("s_waitcnt vmcnt(0)" ::: "memory"); LDS_WAIT(); __builtin_amdgcn_s_barrier(); asm volatile("" ::: "memory");
}

struct Args { const float* in[22]; float* out; unsigned char* ws; int ph_lo, ph_hi; };
static_assert(sizeof(Args) == 22 * 8 + 8 + 8 + 8, "Args has no padding");

__global__ void __launch_bounds__(512, 2) mk_fwd(Args args) {
    extern __shared__ __attribute__((aligned(16))) unsigned char lds_raw[];
    LAS unsigned char* lds = (LAS unsigned char*)lds_raw;
    volatile LAS unsigned* MISC = (volatile LAS unsigned*)(lds + MISC_OFF);
    const int wave = __builtin_amdgcn_readfirstlane(threadIdx.x >> 6);
    const int G = gridDim.x; const int bx = blockIdx.x; const int vcu = (G % 8 == 0) ? (bx % 8) * (G / 8) + bx / 8 : bx;
    unsigned char* ws = args.ws;
    unsigned* ctl = (unsigned*)(ws + WS_CTL);
    for (int u = threadIdx.x; u < (LDS_BYTES - MISC_OFF) / 4; u += 512) ((LAS unsigned*)(lds + MISC_OFF))[u] = 0u;
    __syncthreads();
    XcdBarrier bar; bar.bar = ctl + CW_BAR; bar.x = 0; bar.st = nullptr;
    if (MK_N_LAUNCHES == 1) bar = xcd_barrier_post(ctl + CW_BAR, MISC + 8);
    const int lo = args.ph_lo, hi = args.ph_hi;
#define IN(k) (lo <= (k) && (k) < hi)
#define BOTH(k) (IN(k) && IN((k) + 1))
#define GRID_BAR() do { if (MK_N_LAUNCHES == 1) xcd_barrier(bar); } while (0)

    const float* x = args.in[0]; const float* pin = args.in[1]; const float* g_mix = args.in[2]; const float* w_in = args.in[3];
    const float* g_v = args.in[4]; const float* gws = args.in[5]; const float* gbs = args.in[6]; const float* g_q = args.in[7]; const float* g_k = args.in[8];
    const float* rpb = args.in[9]; const float* g_oa = args.in[10]; const float* g_ob = args.in[11]; const float* w_out = args.in[12]; const float* g_ffn = args.in[13];
    const float* w_up = args.in[14]; const float* conv_w = args.in[15]; const float* conv_b = args.in[16]; const float* w_down = args.in[17]; const float* g_ple = args.in[18];
    const float* w_g = args.in[19]; const float* w_p = args.in[20]; const float* g_post = args.in[21];
    float* out = args.out;
    bf16_t* WinT = (bf16_t*)(ws + WS_WIN); bf16_t* WoutT = (bf16_t*)(ws + WS_WOUT); bf16_t* WupT = (bf16_t*)(ws + WS_WUP); bf16_t* WdnT = (bf16_t*)(ws + WS_WDN);
    bf16_t* WgT = (bf16_t*)(ws + WS_WG); bf16_t* WpT = (bf16_t*)(ws + WS_WP); bf16_t* WSb = (bf16_t*)(ws + WS_WS); bf16_t* PB = (bf16_t*)(ws + WS_PB);
    bf16_t* XA = (bf16_t*)(ws + WS_XA); bf16_t* EB = (bf16_t*)(ws + WS_E); bf16_t* Z = (bf16_t*)(ws + WS_Z); bf16_t* MIX = (bf16_t*)(ws + WS_MIX); bf16_t* ACT = (bf16_t*)(ws + WS_ACT);
    unsigned* CMAX2 = (unsigned*)(ws + WS_CMAX2); float* RSN = (float*)(ws + WS_RSN); unsigned char* WIN8 = ws + WS_WIN8;
    unsigned* CMAXG = (unsigned*)(ws + WS_CMAXG); float* RSB = (float*)(ws + WS_RSB);
    unsigned* CMAX = (unsigned*)(ws + WS_CMAX); float* RSF = (float*)(ws + WS_RSF); unsigned char* A8H = ws + WS_A8H;
    float* STA = (float*)(ws + WS_STA); float* STB = (float*)(ws + WS_STB); float* STE = (float*)(ws + WS_STE); float* EDGE = (float*)(ws + WS_EDGE);
    LAS float* epiP = (LAS float*)(lds + EPI_P); LAS f32x4* epiH = (LAS f32x4*)(lds + EPI_H); LAS float* epiRS = (LAS float*)(lds + EPI_RS);

    if (IN(0)) {
        const int lane = lane_id(), gw = vcu * 8 + wave, NGW = G * 8;
        constexpr int NI_UP = (DM / 256) * (DUP / 512), NI_IN = (DM / 256) * ((I8_R1 - I8_R0) / 512), NI_G = (DM / 256) * (DM / 512);
        for (int ci = vcu; ci < NI_UP + NI_IN + NI_G; ci += G) {
            if (ci < NI_UP) colmax_item<true>(w_up, DUP, 0, DUP / 512, g_ffn, CMAX, ci, wave, lane, (LAS float*)lds);
            else if (ci < NI_UP + NI_IN) colmax_item<false>(w_in, DIN, I8_R0, (I8_R1 - I8_R0) / 512, nullptr, CMAX2, ci - NI_UP, wave, lane, (LAS float*)lds);
            else colmax_item<true>(w_g, DM, 0, DM / 512, g_ple, CMAXG, ci - NI_UP - NI_IN, wave, lane, (LAS float*)lds);
        }
        if (BOTH(0)) GRID_BAR();
    }
    if (IN(1)) {
      for (int rep0 = 0; rep0 < REP0; ++rep0) {
        LAS float* scr = (LAS float*)(lds + wave * 16384);
        const int lane = lane_id(), tid = wave * 64 + lane;
        const int gw = vcu * 8 + wave, NGW = G * 8;
        p0_pipe(w_in, DIN, DIN / 32, (DM / 64) * (DIN / 32), gw, NGW, lane, [&](const float (&v)[32], int k0, int n0) {
            if (n0 >= I8_R0 && n0 < I8_R1) p0_finish_i8(v, DM, WIN8, n0, nullptr, CMAX2, n0, scr, k0, lane);
            else p0_finish_bf16(v, DM, WinT, n0, nullptr, scr, k0, lane); });
        p0_pipe(w_out, DM, DM / 32, (DM / 64) * (DM / 32), gw, NGW, lane, [&](const float (&v)[32], int k0, int n0) { p0_finish_bf16(v, DM, WoutT, n0, nullptr, scr, k0, lane); });
        p0_pipe(w_up, DUP, DUP / 32, (DM / 64) * (DUP / 32), gw, NGW, lane, [&](const float (&v)[32], int k0, int n0) {
            const int orow = (n0 < DFF) ? 256 * (n0 >> 7) + (n0 & 127) : 256 * ((n0 - DFF) >> 7) + 128 + ((n0 - DFF) & 127);
            p0_finish_i8(v, DM, (unsigned char*)WupT, orow, g_ffn, CMAX, n0, scr, k0, lane); });
        p0_pipe(w_down, DM, DM / 32, (DFF / 64) * (DM / 32), gw, NGW, lane, [&](const float (&v)[32], int k0, int n0) { p0_finish_bf16(v, DFF, WdnT, n0, nullptr, scr, k0, lane); });
        p0_pipe(w_g, DM, DM / 32, (DM / 64) * (DM / 32), gw, NGW, lane, [&](const float (&v)[32], int k0, int n0) { p0_finish_i8(v, DM, (unsigned char*)WgT, n0, g_ple, CMAXG, n0, scr, k0, lane); });
        p0_pipe(w_p, DM, DM / 32, (DPLE / 64) * (DM / 32), gw, NGW, lane, [&](const float (&v)[32], int k0, int n0) { p0_finish_bf16(v, DPLE, WpT, n0, nullptr, scr, k0, lane); });
        f32x4 vnx[16];
#pragma unroll
        for (int j = 0; j < 16; ++j) vnx[j] = (f32x4){0.f, 0.f, 0.f, 0.f};
        if (gw < M) { const f32x4* xr = (const f32x4*)(x + (size_t)gw * DM) + lane;
#pragma unroll
            for (int j = 0; j < 16; ++j) vnx[j] = xr[64 * j]; }
        for (int m = gw; m < M; m += NGW) {
            f32x4 v[16]; float s = 0.f;
#pragma unroll
            for (int j = 0; j < 16; ++j) { v[j] = vnx[j]; s += pg8::sumsq4(v[j]); }
            if (m + NGW < M) { const f32x4* xr = (const f32x4*)(x + (size_t)(m + NGW) * DM) + lane;
#pragma unroll
                for (int j = 0; j < 16; ++j) vnx[j] = xr[64 * j]; }
            const float r = rsqrtf(wave_sum(s) * (1.0f / DM) + EPS);
            u32x2* o8 = (u32x2*)(XA + (size_t)m * DM) + lane;
            float mx = 0.f;
#pragma unroll
            for (int j = 0; j < 16; ++j) { const f32x4 gg = *((const f32x4*)g_mix + lane + 64 * j); const f32x4 y = v[j] * r * gg; v[j] = y; u32x2 o; o.x = pk2(y[0], y[1]); o.y = pk2(y[2], y[3]); o8[64 * j] = o;
                const f32x4 ay = __builtin_elementwise_abs(y); mx = fmaxf(mx, fmaxf(fmaxf(ay[0], ay[1]), fmaxf(ay[2], ay[3]))); }
            mx = wave_max(mx);
            const float inv = mx > 0.f ? 127.0f / mx : 0.f;
            unsigned* o4 = (unsigned*)(A8H + (size_t)m * DM) + lane;
#pragma unroll
            for (int j = 0; j < 16; ++j) o4[64 * j] = pg8::pk4_i8(v[j] * inv);
            if (lane == 0) RSN[m] = mx * (1.0f / 127.0f);
        }
        const int gt = vcu * 512 + tid, NGT = G * 512;
        for (int i = gt; i < M * DPLE / 4; i += NGT) { const f32x4 v = ((const f32x4*)pin)[i]; u32x2 o; o.x = pk2(v[0], v[1]); o.y = pk2(v[2], v[3]); ((u32x2*)PB)[i] = o; }
        for (int i = gt; i < NH * 128 * 128 / 4; i += NGT) { const f32x4 v = ((const f32x4*)gws)[i]; u32x2 o; o.x = pk2(v[0], v[1]); o.y = pk2(v[2], v[3]); ((u32x2*)WSb)[i] = o; }
        if (REP0 > 1) __syncthreads();
      }
        if (BOTH(1)) GRID_BAR();
    }
    if (IN(2)) {
        { pg8::Gemm gm{(const bf16_t*)A8H, (const bf16_t*)WIN8, M, DIN, DM / 2}; pg8::MapOrder S; S.init(M, I8_R1 - I8_R0, G, bx); S.lo_n = 0; S.gap = I8_R0 / 256;
          int rs_pm = -1;
          pg8::EpiZ<true> E{Z, g_v, g_q, g_k, epiP, RSN, CMAX2, epiRS, &rs_pm};
          pg8::gemm_phase<pg8::EpiZ<true>, pg8::MapOrder, false, 2>(lds, gm, S, E, wave); }
        { pg8::Gemm gm{XA, WinT, M, DIN, DM}; pg8::MapOrder S; S.init(M, DIN - (I8_R1 - I8_R0), G, bx); S.lo_n = I8_R0 / 256; S.gap = (I8_R1 - I8_R0) / 256;
          pg8::EpiZ<false> E{Z, g_v, g_q, g_k, epiP, nullptr, nullptr, nullptr, nullptr};
          pg8::gemm_phase<pg8::EpiZ<false>, pg8::MapOrder>(lds, gm, S, E, wave); }
        if (BOTH(2)) GRID_BAR();
    }
    if (IN(3)) {
      for (int rep2 = 0; rep2 < REP2; ++rep2) {
        gate_phase(lds, Z, Z + (size_t)1 * M * DG, WSb, gbs, g_oa, MIX, vcu, G, wave);
        na_phase(lds, (LAS float*)(lds + EPI_P), Z + (size_t)2 * M * DG, Z + (size_t)3 * M * DG, Z + (size_t)4 * M * DG, rpb, g_ob, MIX, vcu, G, wave);
      }
        if (BOTH(3)) GRID_BAR();
    }
    if (IN(4)) {
        pg8::Gemm gm{MIX, WoutT, M, DM, DM}; pg8::StaticOrder S; S.init(M, DM, G, bx);
        pg8::EpiRes E{x, nullptr, nullptr, XA, nullptr, DM, epiP};
        pg8::gemm_phase<pg8::EpiRes, pg8::StaticOrder>(lds, gm, S, E, wave);
#if REP3 > 1
        __syncthreads(); pg8::gemm_phase<pg8::EpiRes, pg8::StaticOrder>(lds, gm, S, E, wave);
#endif
        if (BOTH(4)) GRID_BAR();
    }
    if (IN(5)) {
        const int lane = lane_id(), gw = vcu * 8 + wave, NGW = G * 8;
        for (int m = gw; m < M; m += NGW) {
            const u32x4* src = (const u32x4*)(XA + (size_t)m * DM) + lane;
            u32x4 w[8]; float mx = 0.f, ss = 0.f;
#pragma unroll
            for (int j = 0; j < 8; ++j) w[j] = src[64 * j];
#pragma unroll
            for (int j = 0; j < 8; ++j) { f32x4 a, b; pg8::bf8_to_f32(w[j], a, b); ss += pg8::sumsq4(a) + pg8::sumsq4(b);
                const f32x4 ab = __builtin_elementwise_max(__builtin_elementwise_abs(a), __builtin_elementwise_abs(b)); mx = fmaxf(mx, fmaxf(fmaxf(ab[0], ab[1]), fmaxf(ab[2], ab[3]))); }
            mx = wave_max(mx); ss = wave_sum(ss);
            const float inv = mx > 0.f ? 127.0f / mx : 0.f;
            u32x2* dst = (u32x2*)(A8H + (size_t)m * DM) + lane;
#pragma unroll
            for (int j = 0; j < 8; ++j) { f32x4 a, b; pg8::bf8_to_f32(w[j], a, b); u32x2 o; o.x = pg8::pk4_i8(a * inv); o.y = pg8::pk4_i8(b * inv); dst[64 * j] = o; }
            if (lane == 0) RSF[m] = rsqrtf(ss * (1.0f / DM) + EPS) * mx * (1.0f / 127.0f);
        }
        if (BOTH(5)) GRID_BAR();
    }
    if (IN(6)) {
        pg8::Gemm gm{(const bf16_t*)A8H, WupT, M, DUP, DM / 2}; pg8::StaticOrder S; S.init(M, DUP, G, bx);
        int rs_pm = -1;
        pg8::EpiUp E{ACT, RSF, CMAX, conv_w, conv_b, EDGE, epiRS, epiH, &rs_pm, epiP};
        pg8::gemm_phase<pg8::EpiUp, pg8::StaticOrder, false, 2>(lds, gm, S, E, wave);
        { pg8::Gemm gm2{PB, WpT, M, DM, DPLE}; pg8::TailOrder S2; S2.init_tail(M, DM, G, bx, (M / 256) * (DUP / 256));
          pg8::EpiRes E2{nullptr, nullptr, nullptr, EB, STE, DM, epiP};
          pg8::gemm_phase<pg8::EpiRes, pg8::TailOrder>(lds, gm2, S2, E2, wave); }
        if (BOTH(6)) GRID_BAR();
    }
    if (IN(7)) {
        const int gt = vcu * 512 + wave * 64 + lane_id(), NGT = G * 512;
        const int per_row = DFF / 4, total = 64 * 2 * per_row;
        for (int i = gt; i < total; i += NGT) {
            const int pr = i / per_row, j = (i - pr * per_row) * 4, pm = pr >> 1, which = pr & 1;
            const float* e0 = EDGE + (size_t)pm * 4 * DUP;
            f32x4 res[2];
#pragma unroll
            for (int bj = 0; bj < 2; ++bj) {
                const int ch = j + bj * DFF;
                f32x4 pv = {0.f, 0.f, 0.f, 0.f}, cv, nv = {0.f, 0.f, 0.f, 0.f};
                if (which == 0) { if (pm % 32 != 0) pv = *(const f32x4*)(e0 - (size_t)4 * DUP + (size_t)3 * DUP + ch); cv = *(const f32x4*)(e0 + ch); nv = *(const f32x4*)(e0 + (size_t)DUP + ch); }
                else { pv = *(const f32x4*)(e0 + (size_t)2 * DUP + ch); cv = *(const f32x4*)(e0 + (size_t)3 * DUP + ch); if (pm % 32 != 31) nv = *(const f32x4*)(e0 + (size_t)4 * DUP + ch); }
                res[bj] = *(const f32x4*)(conv_b + ch) + *(const f32x4*)(conv_w + ch) * pv + *(const f32x4*)(conv_w + DUP + ch) * cv + *(const f32x4*)(conv_w + 2 * DUP + ch) * nv;
            }
            const f32x4 a = pg8::gelu4(res[0]) * res[1];
            u32x2 o; o.x = pg8::cvt_pk_bf16(a[0], a[1]); o.y = pg8::cvt_pk_bf16(a[2], a[3]);
            *(u32x2*)(ACT + (size_t)(pm * 256 + (which ? 255 : 0)) * DFF + j) = o;
        }
        if (BOTH(7)) GRID_BAR();
    }
    if (IN(8)) {
        pg8::Gemm gm{ACT, WdnT, M, DM, DFF}; pg8::StaticOrder S; S.init(M, DM, G, bx);
        pg8::EpiRes E{nullptr, XA, nullptr, XA, nullptr, DM, epiP, nullptr};
        pg8::gemm_phase<pg8::EpiRes, pg8::StaticOrder>(lds, gm, S, E, wave);
        if (BOTH(8)) GRID_BAR();
    }
    if (IN(9)) {
        const int lane = lane_id(), gw = vcu * 8 + wave, NGW = G * 8;
        for (int m = gw; m < M; m += NGW) row_to_i8(XA, ws + WS_A8, RSB, m, lane);
        if (BOTH(9)) GRID_BAR();
    }
    if (IN(10)) {
        pg8::Gemm gm{(const bf16_t*)(ws + WS_A8), WgT, M, DM, DM / 2}; pg8::StaticOrder S; S.init(M, DM, G, bx);
        int rs_pm = -1;
        pg8::EpiGate E{out, XA, EB, RSB, STE, g_post, epiRS, &rs_pm, CMAXG};
        pg8::gemm_phase<pg8::EpiGate, pg8::StaticOrder, false, 2>(lds, gm, S, E, wave);
    }
#undef IN
#undef BOTH
#undef GRID_BAR
}

extern "C" void kernel_launch(void* const* d_in, const int* in_sizes, int n_in, void* d_out, int out_size, void* d_ws, size_t ws_size, hipStream_t stream) {
    static int grid = 0;
    if (grid == 0) {
        if (n_in != 22 || in_sizes[0] != M * DM || out_size != M * DM || ws_size < WS_END) { fprintf(stderr, "kernel_launch: unexpected shapes (n_in %d, in0 %d, out %d, ws %zu)\n", n_in, n_in > 0 ? in_sizes[0] : -1, out_size, ws_size); grid = -1; return; }
        int dev = 0, cus = 0, per_cu = 0;
        if (hipGetDevice(&dev) != hipSuccess || hipDeviceGetAttribute(&cus, hipDeviceAttributeMultiprocessorCount, dev) != hipSuccess) { grid = -1; return; }
        if (hipFuncSetAttribute((const void*)mk_fwd, hipFuncAttributeMaxDynamicSharedMemorySize, LDS_BYTES) != hipSuccess) { fprintf(stderr, "kernel_launch: hipFuncSetAttribute failed\n"); grid = -1; return; }
        if (hipOccupancyMaxActiveBlocksPerMultiprocessor(&per_cu, (const void*)mk_fwd, 512, LDS_BYTES) != hipSuccess || per_cu < 1) { fprintf(stderr, "kernel_launch: occupancy query says %d\n", per_cu); }
        (void)hipGetLastError();
        grid = cus;
    }
    if (grid < 0) return;
    if (hipMemsetAsync((char*)d_ws + WS_CTL, 0, CTL_ZERO_BYTES, stream) != hipSuccess) return;
    Args a{};
    for (int i = 0; i < 22; ++i) a.in[i] = (const float*)d_in[i];
    a.out = (float*)d_out; a.ws = (unsigned char*)d_ws;
    if (MK_N_LAUNCHES == 1) {
        a.ph_lo = 0; a.ph_hi = NPH;
        hipLaunchKernelGGL(mk_fwd, dim3(grid), dim3(512), LDS_BYTES, stream, a);
    } else {
        for (int k = 0; k < NPH; ++k) { a.ph_lo = k; a.ph_hi = k + 1; hipLaunchKernelGGL(mk_fwd, dim3(grid), dim3(512), LDS_BYTES, stream, a); }
    }
}
```

```cpp
#include <hip/hip_runtime.h>
#include <cstdio>
#include <cstdint>

#ifndef MK_N_LAUNCHES
#define MK_N_LAUNCHES 1
#endif

#ifndef ASYM_WAIT
#define ASYM_WAIT 0
#endif
#ifndef DPP_OLD_PREV
#define DPP_OLD_PREV 0
#endif
#ifndef REP0
#define REP0 1
#endif
#ifndef REP1
#define REP1 1
#endif
#ifndef REP7
#define REP7 1
#endif
#ifndef REP3
#define REP3 1
#endif
#ifndef REP4
#define REP4 1
#endif
#ifndef PROBE_D
#define PROBE_D 0
#endif
#ifndef PROBE_STAGGER
#define PROBE_STAGGER 200
#endif
#ifndef REP2
#define REP2 1
#endif
#define LAS __attribute__((address_space(3)))
#define GAS __attribute__((address_space(1)))
typedef unsigned short bf16_t;
typedef short bf16x8 __attribute__((ext_vector_type(8)));
typedef short s16x4 __attribute__((ext_vector_type(4)));
typedef float f32x4 __attribute__((ext_vector_type(4)));
typedef float f32x2 __attribute__((ext_vector_type(2)));
typedef unsigned u32x4 __attribute__((ext_vector_type(4)));
typedef unsigned u32x2 __attribute__((ext_vector_type(2)));
typedef int i32x4 __attribute__((ext_vector_type(4)));
typedef int i32x8 __attribute__((ext_vector_type(8)));

constexpr int BATCH = 2, SEQ = 8192, M = BATCH * SEQ, DM = 4096, DG = 2048, DIN = 10240, DFF = 11008, DUP = 2 * DFF, DPLE = 256, HD = 128, NH = 16;
constexpr float EPS = 1e-6f;
constexpr float LOG2E = 1.4426950408889634f;
constexpr int NPH = 11;

constexpr size_t MiB = 1u << 20;
constexpr size_t WS_CTL = 0, CTL_ZERO_BYTES = 1 * MiB;
constexpr size_t WS_STA = 1 * MiB, WS_STB = 2 * MiB, WS_STE = 3 * MiB;
constexpr size_t WS_WS = 4 * MiB;
constexpr size_t WS_PB = 5 * MiB;
constexpr size_t WS_WP = 13 * MiB;
constexpr size_t WS_EDGE = 16 * MiB;
constexpr size_t WS_WIN = 38 * MiB;
constexpr size_t WS_WOUT = 118 * MiB;
constexpr size_t WS_WUP = 150 * MiB;
constexpr size_t WS_WDN = 322 * MiB;
constexpr size_t WS_WG = 408 * MiB;
constexpr size_t WS_XA = 440 * MiB;
constexpr size_t WS_E = 568 * MiB;
constexpr size_t WS_Z = 696 * MiB;
constexpr size_t WS_MIX = 1016 * MiB;
constexpr size_t WS_ACT = 696 * MiB;
constexpr size_t WS_A8 = 1048 * MiB;
constexpr size_t WS_A8H = 1144 * MiB;
constexpr size_t WS_END = 1208 * MiB;
constexpr size_t WS_CMAX = 256 * 1024;
constexpr size_t WS_RSF = 4 * MiB + 512 * 1024;
constexpr int I8_T0 = 1, I8_T1 = 4;
constexpr int I8_R0 = 2048 * I8_T0, I8_R1 = 2048 * I8_T1;
constexpr size_t WS_CMAX2 = 384 * 1024;
constexpr size_t WS_CMAXG = 432 * 1024;
constexpr size_t WS_RSB = WS_RSF + 128 * 1024;
constexpr size_t WS_RSN = WS_RSF + 64 * 1024;
constexpr size_t WS_WIN8 = 38 * MiB + (size_t)I8_R0 * 4096;
static_assert(WS_CMAX2 >= 256 * 1024 + (size_t)2 * 11008 * 4 && WS_CMAX2 + 10240 * 4 <= 1 * MiB, "cmax arrays inside the zeroed MiB");
static_assert(WS_ACT + (size_t)M * DFF * 2 <= WS_A8 && WS_A8 + (size_t)M * DM <= WS_A8H && WS_A8H + (size_t)M * DM <= WS_END, "fp8 h2 copy, int8 h1 copy");
constexpr float WG_SCALE = 256.0f;
static_assert(WS_ACT + (size_t)M * DFF * 2 <= WS_END, "act overlay");
static_assert(WS_EDGE + (size_t)64 * 4 * DUP * 4 <= WS_WIN, "edge buffer");

constexpr int CW_TMO = 0, CW_BAR = 4096;

constexpr int RING_BYTES = 131072;
constexpr int EPI_P = 131072;
constexpr int EPI_H = 139264;
constexpr int EPI_RS = 147456;
constexpr int MISC_OFF = 149504;
constexpr int LDS_BYTES = 151552;

__device__ __forceinline__ int lane_id() { int l; asm volatile("v_mbcnt_lo_u32_b32 %0, -1, 0\n\tv_mbcnt_hi_u32_b32 %0, -1, %0" : "=v"(l)); return l; }
namespace pg8 {
constexpr int BM = 256, BK = 64, HALF = 128, HTB = HALF * BK * 2, STAGE_BYTES = 8 * HTB, NXCD = 8, WGM = 8;
__host__ __device__ __forceinline__ int lds_byte(int r, int c) { const int st = (r >> 4) * 2 + (c >> 5), rr = r & 15, cc = c & 31, ob = rr * 64 + cc * 2; return st * 1024 + (ob ^ (((ob >> 9) & 1) << 5)); }
__host__ __device__ __forceinline__ void stage_rc(int b, int& R, int& C) { const int st = b / 1024, sb = b % 1024, swz = sb ^ (((sb >> 9) & 1) << 5); R = (st >> 1) * 16 + swz / 64; C = (st & 1) * 32 + (swz % 64) / 2; }
__host__ __device__ __forceinline__ int perm32(int rho) { const int n = rho >> 4, i = rho & 15; return 8 * (i >> 2) + 4 * n + (i & 3); }
struct Unit { int pm, pn; };
struct Gemm { const bf16_t* A; const bf16_t* Bt; int M, N, K, ld; };
struct StaticOrder {
    int nM, nN, nwg, G, c;
    __host__ __device__ void init(int M_, int N_, int G_, int c_) { nM = M_ / BM; nN = N_ / BM; nwg = nM * nN; G = G_; c = c_; }
    __host__ __device__ bool next(int i, Unit& u) const {
        const long L = (long)i * G + c; if (L >= nwg) return false;
        int wgid = (int)L; { const int q = nwg / NXCD, r = nwg % NXCD, xcd = wgid % NXCD, off = wgid / NXCD; wgid = (xcd < r ? xcd * (q + 1) : r * (q + 1) + (xcd - r) * q) + off; }
        const int nig = WGM * nN, gid = wgid / nig, fm = gid * WGM, gsz = (nM - fm) < WGM ? (nM - fm) : WGM;
        u.pm = fm + ((wgid % nig) % gsz); u.pn = (wgid % nig) / gsz; return true;
    }
};
__device__ __forceinline__ unsigned cvt_pk_bf16(float lo, float hi) { unsigned r; asm volatile("v_cvt_pk_bf16_f32 %0, %1, %2" : "=v"(r) : "v"(lo), "v"(hi)); return r; }
__device__ __forceinline__ f32x2 gelu_pk(f32x2 v) {
    const f32x2 av = __builtin_elementwise_abs(v), d = av * 0.2316418882f + 1.0f;
    f32x2 t; t.x = __builtin_amdgcn_rcpf(d.x); t.y = __builtin_amdgcn_rcpf(d.y);
    f32x2 q = t * 0.5307027145f + (-0.7265760135f); q = q * t + 0.7107068705f; q = q * t + (-0.142248368f); q = q * t + 0.127414796f; q = q * t;
    const f32x2 s = (v * v) * (-0.72134752044f);
    f32x2 e; e.x = __builtin_amdgcn_exp2f(s.x); e.y = __builtin_amdgcn_exp2f(s.y);
    const f32x2 m = v * (q * e), r = v - m;
    f32x2 o; o.x = v.x < 0.f ? m.x : r.x; o.y = v.y < 0.f ? m.y : r.y; return o;
}
__device__ __forceinline__ f32x4 gelu4(f32x4 v) { const f32x2 a = gelu_pk((f32x2){v[0], v[1]}), b = gelu_pk((f32x2){v[2], v[3]}); return (f32x4){a.x, a.y, b.x, b.y}; }
__device__ __forceinline__ float sumsq4(f32x4 v) { return (v[0] * v[0] + v[1] * v[1]) + (v[2] * v[2] + v[3] * v[3]); }
__device__ __forceinline__ float xsum_fq(float s) { s += __shfl_xor(s, 16); s += __shfl_xor(s, 32); return s; }
#define EPI_BAR() do { asm volatile("s_waitcnt lgkmcnt(0)" ::: "memory"); __builtin_amdgcn_s_barrier(); asm volatile("" ::: "memory"); } while (0)


template <bool I8>
struct EpiZ {
    bf16_t* Z; const float* gv; const float* gq; const float* gk; LAS float* P; const float* rsn; const unsigned* cm; LAS float* RS; int* rs_pm;
    __device__ __forceinline__ void operator()(f32x4 (&acc)[2][2][4][2], const Unit& u, const int wr, const int wc, const int wid) const {
        const int lane = lane_id(), fr = lane & 15, fq = lane >> 4, tid = wid * 64 + lane;
        const int t = u.pn >> 3, ct = (u.pn & 7) * 256;
        if constexpr (I8) {
            if (__builtin_amdgcn_readfirstlane(*rs_pm) != u.pm) {
                if (tid < 256) RS[tid] = rsn[u.pm * BM + tid] * (1.0f / 127.0f);
                EPI_BAR(); *rs_pm = u.pm;
            }
            float rr[2][4];
#pragma unroll
            for (int ai = 0; ai < 2; ++ai)
#pragma unroll
                for (int m = 0; m < 4; ++m) rr[ai][m] = RS[ai * HALF + wr * 64 + m * 16 + fr];
#pragma unroll
            for (int bj = 0; bj < 2; ++bj)
#pragma unroll
                for (int n = 0; n < 2; ++n) {
                    const u32x4 cmb = *(const u32x4*)(cm + u.pn * 256 + bj * 128 + wc * 32 + 8 * fq + 4 * n);
                    const f32x4 ws4 = {__uint_as_float(cmb.x), __uint_as_float(cmb.y), __uint_as_float(cmb.z), __uint_as_float(cmb.w)};
#pragma unroll
                    for (int ai = 0; ai < 2; ++ai)
#pragma unroll
                        for (int m = 0; m < 4; ++m) { acc[ai][bj][m][n] = __builtin_convertvector(__builtin_bit_cast(i32x4, acc[ai][bj][m][n]), f32x4) * (ws4 * rr[ai][m]);
                            asm volatile("" : "+v"(acc[ai][bj][m][n])); }
                    __builtin_amdgcn_sched_barrier(0);
                }
        }
        if (t <= 1) {
#pragma unroll
            for (int ai = 0; ai < 2; ++ai)
#pragma unroll
                for (int bj = 0; bj < 2; ++bj)
#pragma unroll
                    for (int m = 0; m < 4; ++m)
#pragma unroll
                        for (int n = 0; n < 2; ++n) acc[ai][bj][m][n] = gelu4(acc[ai][bj][m][n]);
        }
        if (t >= 1 && t <= 3) {
#pragma unroll
            for (int ai = 0; ai < 2; ++ai)
#pragma unroll
                for (int m = 0; m < 4; ++m)
#pragma unroll
                    for (int bj = 0; bj < 2; ++bj) {
                        float s = sumsq4(acc[ai][bj][m][0]) + sumsq4(acc[ai][bj][m][1]); s = xsum_fq(s);
                        if (fq == 0) P[(bj * 256 + ai * 128 + wr * 64 + m * 16 + fr) * 4 + wc] = s;
                    }
            EPI_BAR();
            const float* gsrc = (t == 1) ? (gv + (u.pn & 7) * 256) : (t == 2 ? gq : gk);
#pragma unroll
            for (int bj = 0; bj < 2; ++bj) {
                const float* gp = gsrc + ((t == 1) ? bj * 128 : 0) + wc * 32 + 8 * fq;
                const f32x4 g0 = *(const f32x4*)gp, g1 = *(const f32x4*)(gp + 4);
#pragma unroll
                for (int ai = 0; ai < 2; ++ai)
#pragma unroll
                    for (int m = 0; m < 4; ++m) {
                        const f32x4 p4 = *(const LAS f32x4*)&P[(bj * 256 + ai * 128 + wr * 64 + m * 16 + fr) * 4];
                        const float r = rsqrtf(((p4[0] + p4[1]) + (p4[2] + p4[3])) * (1.0f / 128.0f) + EPS);
                        acc[ai][bj][m][0] = acc[ai][bj][m][0] * r * g0; acc[ai][bj][m][1] = acc[ai][bj][m][1] * r * g1;
                    }
            }
        }
        bf16_t* base = Z + (size_t)t * M * DG;
#pragma unroll
        for (int ai = 0; ai < 2; ++ai)
#pragma unroll
            for (int m = 0; m < 4; ++m) {
                bf16_t* rowp = base + (size_t)(u.pm * BM + ai * HALF + wr * 64 + m * 16 + fr) * DG + ct + wc * 32 + 8 * fq;
#pragma unroll
                for (int bj = 0; bj < 2; ++bj) {
                    const f32x4 v0 = acc[ai][bj][m][0], v1 = acc[ai][bj][m][1];
                    u32x4 w; w.x = cvt_pk_bf16(v0[0], v0[1]); w.y = cvt_pk_bf16(v0[2], v0[3]); w.z = cvt_pk_bf16(v1[0], v1[1]); w.w = cvt_pk_bf16(v1[2], v1[3]);
                    *(u32x4*)(rowp + bj * HALF) = w;
                }
            }
    }
};

__device__ __forceinline__ unsigned pk4_fp8(float a, float b, float c, float d) {
    int p = 0; p = __builtin_amdgcn_cvt_pk_fp8_f32(a, b, p, false); p = __builtin_amdgcn_cvt_pk_fp8_f32(c, d, p, true); return (unsigned)p; }
__device__ __forceinline__ unsigned pk4_i8(f32x4 v) {
    const int a = (int)__builtin_rintf(v[0]), b = (int)__builtin_rintf(v[1]), c = (int)__builtin_rintf(v[2]), d = (int)__builtin_rintf(v[3]);
    return (unsigned)(a & 255) | ((unsigned)(b & 255) << 8) | ((unsigned)(c & 255) << 16) | ((unsigned)d << 24); }
__device__ __forceinline__ void bf8_to_f32(const u32x4 w, f32x4& a, f32x4& b) {
    a[0] = __uint_as_float(w.x << 16); a[1] = __uint_as_float(w.x & 0xffff0000u); a[2] = __uint_as_float(w.y << 16); a[3] = __uint_as_float(w.y & 0xffff0000u);
    b[0] = __uint_as_float(w.z << 16); b[1] = __uint_as_float(w.z & 0xffff0000u); b[2] = __uint_as_float(w.w << 16); b[3] = __uint_as_float(w.w & 0xffff0000u);
}
struct EpiRes {
    const float* base; const bf16_t* baseb; float* outf; bf16_t* outb; float* stats; int ldc; LAS float* P; unsigned char* out8 = nullptr;
    template <int MB>
    __device__ __forceinline__ void batch(f32x4 (&acc)[2][2][4][2], const Unit& u, const int ai, const int bj, const int mb, const int wr, const int fr, const int col0, float (&ss)[4]) const {
        f32x4 b0[MB], b1[MB]; u32x4 bb[MB];
#pragma unroll
        for (int q = 0; q < MB; ++q) { const int m = mb + q;
            const size_t off = (size_t)(u.pm * BM + ai * HALF + wr * 64 + m * 16 + fr) * ldc + col0 + bj * HALF;
            if (base) { b0[q] = *(const f32x4*)(base + off); b1[q] = *(const f32x4*)(base + off + 4); }
            if (baseb) bb[q] = *(const u32x4*)(baseb + off);
        }
#pragma unroll
        for (int q = 0; q < MB; ++q) { const int m = mb + q;
            const size_t off = (size_t)(u.pm * BM + ai * HALF + wr * 64 + m * 16 + fr) * ldc + col0 + bj * HALF;
            f32x4 v0 = acc[ai][bj][m][0], v1 = acc[ai][bj][m][1];
            if (base) { v0 += b0[q]; v1 += b1[q]; }
            if (baseb) { f32x4 r0, r1; bf8_to_f32(bb[q], r0, r1); v0 += r0; v1 += r1; }
            if (outf) { *(f32x4*)(outf + off) = v0; *(f32x4*)(outf + off + 4) = v1; }
            if (outb) { u32x4 w; w.x = cvt_pk_bf16(v0[0], v0[1]); w.y = cvt_pk_bf16(v0[2], v0[3]); w.z = cvt_pk_bf16(v1[0], v1[1]); w.w = cvt_pk_bf16(v1[2], v1[3]); *(u32x4*)(outb + off) = w; }
            if (out8) { u32x2 w8; w8.x = pk4_fp8(v0[0], v0[1], v0[2], v0[3]); w8.y = pk4_fp8(v1[0], v1[1], v1[2], v1[3]); *(u32x2*)(out8 + off) = w8; }
            ss[m] += sumsq4(v0) + sumsq4(v1);
        }
    }
    __device__ __forceinline__ void operator()(f32x4 (&acc)[2][2][4][2], const Unit& u, const int wr, const int wc, const int wid) const {
        const int lane = lane_id(), fr = lane & 15, fq = lane >> 4, tid = wid * 64 + lane;
        const int col0 = u.pn * BM + wc * 32 + 8 * fq;
#pragma unroll
        for (int ai = 0; ai < 2; ++ai) {
            float ss[4] = {0.f, 0.f, 0.f, 0.f};
#pragma unroll
            for (int bj = 0; bj < 2; ++bj) {
                if (base) { batch<2>(acc, u, ai, bj, 0, wr, fr, col0, ss); batch<2>(acc, u, ai, bj, 2, wr, fr, col0, ss); }
                else batch<4>(acc, u, ai, bj, 0, wr, fr, col0, ss);
            }
            if (stats) {
#pragma unroll
                for (int m = 0; m < 4; ++m) { const float sx = xsum_fq(ss[m]); if (fq == 0) P[(ai * HALF + wr * 64 + m * 16 + fr) * 4 + wc] = sx; }
            }
        }
        if (stats) {
            EPI_BAR();
            if (tid < 256) { const f32x4 p4 = *(const LAS f32x4*)&P[tid * 4]; stats[(size_t)u.pn * M + u.pm * BM + tid] = (p4[0] + p4[1]) + (p4[2] + p4[3]); }
        }
    }
};

__device__ __forceinline__ float rstd_from_parts(const float* st, int row) {
    float s = 0.f;
#pragma unroll
    for (int j = 0; j < 16; ++j) s += st[(size_t)j * M + row];
    return rsqrtf(s * (1.0f / 4096.0f) + EPS);
}
__device__ __forceinline__ float row_prev(float v) { return __builtin_bit_cast(float, __builtin_amdgcn_update_dpp(0, __builtin_bit_cast(int, v), 0x121, 0xF, 0xF, true)); }
__device__ __forceinline__ float row_next(float v) { return __builtin_bit_cast(float, __builtin_amdgcn_update_dpp(0, __builtin_bit_cast(int, v), 0x12F, 0xF, 0xF, true)); }

struct EpiUp {
    bf16_t* act; const float* rsf; const unsigned* cmax; const float* cw; const float* cb; float* edge; LAS float* RS; LAS f32x4* H; int* rs_pm; LAS float* PRM;
    __device__ __forceinline__ void operator()(f32x4 (&acc)[2][2][4][2], const Unit& u, const int wr, const int wc, const int wid) const {
        const int lane = lane_id(), fr = lane & 15, fq = lane >> 4, tid = wid * 64 + lane;
        if (__builtin_amdgcn_readfirstlane(*rs_pm) != u.pm) {
            if (tid < 256) RS[tid] = rsf[u.pm * BM + tid] * (1.0f / 127.0f);
            EPI_BAR(); *rs_pm = u.pm;
        }
        {
            float rr[2][4];
#pragma unroll
            for (int ai = 0; ai < 2; ++ai)
#pragma unroll
                for (int m = 0; m < 4; ++m) rr[ai][m] = RS[ai * HALF + wr * 64 + m * 16 + fr];
#pragma unroll
            for (int bj = 0; bj < 2; ++bj)
#pragma unroll
                for (int n = 0; n < 2; ++n) {
                    const u32x4 cmb = *(const u32x4*)(cmax + u.pn * 128 + wc * 32 + 8 * fq + 4 * n + bj * DFF);
                    const f32x4 ws4 = {__uint_as_float(cmb.x), __uint_as_float(cmb.y), __uint_as_float(cmb.z), __uint_as_float(cmb.w)};
#pragma unroll
                    for (int ai = 0; ai < 2; ++ai)
#pragma unroll
                        for (int m = 0; m < 4; ++m) { acc[ai][bj][m][n] = __builtin_convertvector(__builtin_bit_cast(i32x4, acc[ai][bj][m][n]), f32x4) * (ws4 * rr[ai][m]);
                            asm volatile("" : "+v"(acc[ai][bj][m][n])); }
                    __builtin_amdgcn_sched_barrier(0);
                }
        }
        if (tid < 256) { const int ch = (tid < 128) ? u.pn * 128 + tid : DFF + u.pn * 128 + (tid - 128);
            PRM[tid] = cw[ch]; PRM[256 + tid] = cw[DUP + ch]; PRM[512 + tid] = cw[2 * DUP + ch]; PRM[768 + tid] = cb[ch]; }
#pragma unroll
        for (int ai = 0; ai < 2; ++ai) {
            if (fr == 0) {
#pragma unroll
                for (int bj = 0; bj < 2; ++bj)
#pragma unroll
                    for (int n = 0; n < 2; ++n) H[((((ai * 2 + wr) * 2 + 0) * 4 + wc) * 4 + fq) * 4 + bj * 2 + n] = acc[ai][bj][0][n];
            }
            if (fr == 15) {
#pragma unroll
                for (int bj = 0; bj < 2; ++bj)
#pragma unroll
                    for (int n = 0; n < 2; ++n) H[((((ai * 2 + wr) * 2 + 1) * 4 + wc) * 4 + fq) * 4 + bj * 2 + n] = acc[ai][bj][3][n];
            }
        }
        {
            const int chan = u.pn * 128 + wc * 32 + 8 * fq;
            if (wr == 0 && fr < 2) {
                float* ep = edge + ((size_t)u.pm * 4 + fr) * DUP + chan;
#pragma unroll
                for (int bj = 0; bj < 2; ++bj)
#pragma unroll
                    for (int n = 0; n < 2; ++n) *(f32x4*)(ep + bj * DFF + 4 * n) = acc[0][bj][0][n];
            }
            if (wr == 1 && fr >= 14) {
                float* ep = edge + ((size_t)u.pm * 4 + 2 + (fr - 14)) * DUP + chan;
#pragma unroll
                for (int bj = 0; bj < 2; ++bj)
#pragma unroll
                    for (int n = 0; n < 2; ++n) *(f32x4*)(ep + bj * DFF + 4 * n) = acc[1][bj][3][n];
            }
        }
        EPI_BAR();
        const f32x4 z4 = {0.f, 0.f, 0.f, 0.f};
        u32x2 keep[2][4];
#pragma unroll
        for (int n = 0; n < 2; ++n) {
            const int cg0 = u.pn * 128 + wc * 32 + 8 * fq + 4 * n;
#pragma unroll
            for (int ai = 0; ai < 2; ++ai) {
                f32x4 cgate[4];
#pragma unroll
                for (int bj = 0; bj < 2; ++bj) {
                    const int ch = cg0 + bj * DFF;
                    const int pl = bj * 128 + wc * 32 + 8 * fq + 4 * n; (void)ch;
                    const f32x4 W0 = *(const LAS f32x4*)(PRM + pl), W1 = *(const LAS f32x4*)(PRM + 256 + pl), W2 = *(const LAS f32x4*)(PRM + 512 + pl), CB = *(const LAS f32x4*)(PRM + 768 + pl);
                    f32x4 hp, hn;
                    if (wr == 1) hp = H[((((ai * 2 + 0) * 2 + 1) * 4 + wc) * 4 + fq) * 4 + bj * 2 + n];
                    else if (ai == 1) hp = H[((((0 * 2 + 1) * 2 + 1) * 4 + wc) * 4 + fq) * 4 + bj * 2 + n];
                    else hp = z4;
                    if (wr == 0) hn = H[((((ai * 2 + 1) * 2 + 0) * 4 + wc) * 4 + fq) * 4 + bj * 2 + n];
                    else if (ai == 0) hn = H[((((1 * 2 + 0) * 2 + 0) * 4 + wc) * 4 + fq) * 4 + bj * 2 + n];
                    else hn = z4;
                    f32x4 tprow = hp;
                    f32x4 un;
#pragma unroll
                    for (int e = 0; e < 4; ++e) un[e] = row_next(acc[ai][bj][0][n][e]);
#pragma unroll
                    for (int m = 0; m < 4; ++m) {
                        const f32x4 xv = acc[ai][bj][m][n];
                        f32x4 t, unx = hn;
#pragma unroll
                        for (int e = 0; e < 4; ++e) t[e] = row_prev(xv[e]);
                        if (m < 3) {
#pragma unroll
                            for (int e = 0; e < 4; ++e) unx[e] = row_next(acc[ai][bj][m < 3 ? m + 1 : 3][n][e]);
                        }
#if DPP_OLD_PREV
                        f32x4 pv;
#pragma unroll
                        for (int e = 0; e < 4; ++e) pv[e] = __builtin_bit_cast(float, __builtin_amdgcn_update_dpp(__builtin_bit_cast(int, tprow[e]), __builtin_bit_cast(int, xv[e]), 0x111, 0xF, 0xF, false));
#else
                        const f32x4 pv = (fr == 0) ? tprow : t;
#endif
                        const f32x4 nv = (fr == 15) ? unx : un;
                        const f32x4 c = CB + W0 * pv + W1 * xv + W2 * nv;
                        tprow = t; un = unx;
                        if (bj == 0) cgate[m] = c;
                        else {
                            const f32x4 a = gelu4(cgate[m]) * c;
                            u32x2 w; w.x = cvt_pk_bf16(a[0], a[1]); w.y = cvt_pk_bf16(a[2], a[3]);
                            if (n == 0) keep[ai][m] = w;
                            else { u32x4 w4; w4.x = keep[ai][m].x; w4.y = keep[ai][m].y; w4.z = w.x; w4.w = w.y;
                                *(u32x4*)(act + (size_t)(u.pm * BM + ai * HALF + wr * 64 + m * 16 + fr) * DFF + cg0 - 4) = w4; }
                        }
                    }
                }
            }
        }
    }
};

struct EpiGate {
    float* out; const bf16_t* HB; const bf16_t* E; const float* rsb; const float* statsE; const float* gpost; LAS float* RS; int* rs_pm; const unsigned* cmg;
    __device__ __forceinline__ void operator()(f32x4 (&acc)[2][2][4][2], const Unit& u, const int wr, const int wc, const int wid) const {
        const int lane = lane_id(), fr = lane & 15, fq = lane >> 4, tid = wid * 64 + lane;
        if (__builtin_amdgcn_readfirstlane(*rs_pm) != u.pm) {
            if (tid < 256) { RS[tid] = rsb[u.pm * BM + tid] * (-LOG2E / 127.0f); RS[256 + tid] = rstd_from_parts(statsE, u.pm * BM + tid); }
            EPI_BAR(); *rs_pm = u.pm;
        }
        const int col0 = u.pn * BM + wc * 32 + 8 * fq;
#pragma unroll
        for (int bj = 0; bj < 2; ++bj) {
            const f32x4 g0 = *(const f32x4*)(gpost + col0 + bj * HALF), g1 = *(const f32x4*)(gpost + col0 + bj * HALF + 4);
            const u32x4 cb0 = *(const u32x4*)(cmg + col0 + bj * HALF), cb1 = *(const u32x4*)(cmg + col0 + bj * HALF + 4);
            const f32x4 c0 = {__uint_as_float(cb0.x), __uint_as_float(cb0.y), __uint_as_float(cb0.z), __uint_as_float(cb0.w)}, c1 = {__uint_as_float(cb1.x), __uint_as_float(cb1.y), __uint_as_float(cb1.z), __uint_as_float(cb1.w)};
#pragma unroll
            for (int ai = 0; ai < 2; ++ai) {
                u32x4 eL[4], hL[4];
#pragma unroll
                for (int m = 0; m < 4; ++m) {
                    const size_t off = (size_t)(u.pm * BM + ai * HALF + wr * 64 + m * 16 + fr) * DM + col0 + bj * HALF;
                    eL[m] = *(const u32x4*)(E + off); hL[m] = *(const u32x4*)(HB + off);
                }
#pragma unroll
                for (int m = 0; m < 4; ++m) {
                    const int rl = ai * HALF + wr * 64 + m * 16 + fr; const float r3 = RS[rl], re = RS[256 + rl];
                    const size_t off = (size_t)(u.pm * BM + rl) * DM + col0 + bj * HALF;
                    f32x4 e0, e1, h0, h1;
                    bf8_to_f32(eL[m], e0, e1);
                    bf8_to_f32(hL[m], h0, h1);
                    const f32x4 z0 = __builtin_convertvector(__builtin_bit_cast(i32x4, acc[ai][bj][m][0]), f32x4) * (c0 * r3), z1 = __builtin_convertvector(__builtin_bit_cast(i32x4, acc[ai][bj][m][1]), f32x4) * (c1 * r3);
                    f32x4 s0, s1;
#pragma unroll
                    for (int e = 0; e < 4; ++e) {
                        s0[e] = __builtin_amdgcn_rcpf(1.0f + __builtin_amdgcn_exp2f(z0[e]));
                        s1[e] = __builtin_amdgcn_rcpf(1.0f + __builtin_amdgcn_exp2f(z1[e]));
                    }
                    *(f32x4*)(out + off) = h0 + s0 * (e0 * re * g0);
                    *(f32x4*)(out + off + 4) = h1 + s1 * (e1 * re * g1);
                }
            }
        }
    }
};

struct EpiNone {
    float* sink;
    __device__ __forceinline__ void operator()(f32x4 (&acc)[2][2][4][2], const Unit& u, const int wr, const int wc, const int wid) const {
        const int lane = lane_id(), fr = lane & 15, fq = lane >> 4, tid = wid * 64 + lane;
        f32x4 s = {0.f, 0.f, 0.f, 0.f};
#pragma unroll
        for (int ai = 0; ai < 2; ++ai)
#pragma unroll
            for (int bj = 0; bj < 2; ++bj)
#pragma unroll
                for (int m = 0; m < 4; ++m)
#pragma unroll
                    for (int n = 0; n < 2; ++n) s += acc[ai][bj][m][n];
        if ((s[0] + s[1]) + (s[2] + s[3]) == 123456.789f) sink[tid] = 1.f;
    }
};
struct TailOrder : StaticOrder { int cskip;
    __host__ __device__ void init_tail(int M_, int N_, int G_, int c_, int nwg_main) { const int rem = nwg_main % G_; cskip = rem; StaticOrder::init(M_, N_, G_ - rem, c_ - rem); }
    __host__ __device__ bool next(int i, Unit& u) const { if (c < 0) return false; return StaticOrder::next(i, u); } };
struct MapOrder : StaticOrder { int lo_n, gap;
    __host__ __device__ bool next(int i, Unit& u) const { if (!StaticOrder::next(i, u)) return false; if (u.pn >= lo_n) u.pn += gap; return true; } };
struct MaskOrder : StaticOrder { int mm, mn;
    __host__ __device__ bool next(int i, Unit& u) const { if (!StaticOrder::next(i, u)) return false; u.pm &= mm; u.pn &= mn; return true; } };
struct FixedOrder { int n;
    __host__ __device__ bool next(int i, Unit& u) const { if (i >= n) return false; u.pm = 0; u.pn = 0; return true; } };
template <class Epi, class Sched, bool TILED_UNUSED = false, int MODE = 0>
__device__ __forceinline__ void gemm_phase(LAS unsigned char* lds, const Gemm g, const Sched& S, const Epi& E, const int wid) {
    const int lane = lane_id(), tid = wid * 64 + lane;
    const int wr = wid >> 2, wc = wid & 3, fr = lane & 15, fq = lane >> 4;
    const int K = g.ld ? g.ld : g.K, nt = g.K / BK;
    unsigned voffA, voffB;
    { int R, C; stage_rc(tid * 16, R, C); const int Rb = (R & ~31) + perm32(R & 31); voffA = (unsigned)(R * K + C) * 2u; voffB = (unsigned)(Rb * K + C) * 2u; }
    const size_t pstep = (size_t)64 * K * 2;
    const size_t kstep = (size_t)(BK * 2);
    const size_t hstep = (size_t)HALF * K * 2;
    const size_t tstep = 2 * hstep;
    const unsigned ldsw = (unsigned)wid * 1024u;
    const int aoff = lds_byte(wr * 64 + fr, fq * 8), boff = lds_byte(wc * 32 + fr, fq * 8);
#define PG8_SA(b, h) (((b) * 2 + (h)) * HTB)
#define PG8_SB(b, h) ((4 + (b) * 2 + (h)) * HTB)
#define PG8_STAGE(bufoff, gbase, voff) do { _Pragma("unroll") for (int _i = 0; _i < 2; ++_i) \
        __builtin_amdgcn_global_load_lds((const unsigned*)((const char*)(gbase) + _i * pstep + (voff)), (LAS unsigned*)(lds + (bufoff) + ldsw + _i * 8192), 16, 0, 0); } while (0)
#define PG8_LDA(dst, b, h) do { _Pragma("unroll") for (int m = 0; m < 4; ++m) _Pragma("unroll") for (int k = 0; k < 2; ++k) dst[m][k] = *(const LAS bf16x8*)(lds + PG8_SA(b, h) + aoff + m * 2048 + k * 1024); } while (0)
#define PG8_LDB(dst, b, h) do { _Pragma("unroll") for (int n = 0; n < 2; ++n) _Pragma("unroll") for (int k = 0; k < 2; ++k) dst[n][k] = *(const LAS bf16x8*)(lds + PG8_SB(b, h) + boff + n * 2048 + k * 1024); } while (0)
#define F8_SCALE 0x3f800000
#define F8_OPSEL 2
#define PG8_CAT8(x) __builtin_shufflevector(__builtin_bit_cast(i32x4, (x)[0]), __builtin_bit_cast(i32x4, (x)[1]), 0, 1, 2, 3, 4, 5, 6, 7)
#define PG8_MMA(ai, bj, At, Bt) do { __builtin_amdgcn_s_setprio(1); _Pragma("unroll") for (int m = 0; m < 4; ++m) _Pragma("unroll") for (int n = 0; n < 2; ++n) { \
        if constexpr (MODE == 1) acc[ai][bj][m][n] = __builtin_amdgcn_mfma_scale_f32_16x16x128_f8f6f4(PG8_CAT8(Bt[n]), PG8_CAT8(At[m]), acc[ai][bj][m][n], 0, 0, F8_OPSEL, F8_SCALE, F8_OPSEL, F8_SCALE); \
        else if constexpr (MODE == 2) { _Pragma("unroll") for (int k = 0; k < 2; ++k) acc[ai][bj][m][n] = __builtin_bit_cast(f32x4, __builtin_amdgcn_mfma_i32_16x16x64_i8(__builtin_bit_cast(i32x4, Bt[n][k]), __builtin_bit_cast(i32x4, At[m][k]), __builtin_bit_cast(i32x4, acc[ai][bj][m][n]), 0, 0, 0)); } \
        else { _Pragma("unroll") for (int k = 0; k < 2; ++k) acc[ai][bj][m][n] = __builtin_amdgcn_mfma_f32_16x16x32_bf16(Bt[n][k], At[m][k], acc[ai][bj][m][n], 0, 0, 0); } } \
        __builtin_amdgcn_s_setprio(0); } while (0)
#define PG8_WAIT_V(n) asm volatile("s_waitcnt vmcnt(" #n ")" ::: "memory")
#define PG8_WAIT_L(n) asm volatile("s_waitcnt lgkmcnt(" #n ")" ::: "memory")
#define PG8_BAR __builtin_amdgcn_s_barrier()
#if ASYM_WAIT
#define PG8_WT do { if (wr == 1) PG8_WAIT_V(8); } while (0)
#define PG8_WL do { if (wr == 0) PG8_WAIT_V(8); } while (0)
#else
#define PG8_WT PG8_WAIT_V(8)
#define PG8_WL do { } while (0)
#endif
#define PG8_SCHED __builtin_amdgcn_sched_barrier(0)
    Unit cur, nxt; int ui = 0;
    if (!S.next(0, cur)) return;
    f32x4 acc[2][2][4][2];
#pragma unroll
    for (int a = 0; a < 2; ++a)
#pragma unroll
        for (int b = 0; b < 2; ++b)
#pragma unroll
            for (int m = 0; m < 4; ++m)
#pragma unroll
                for (int n = 0; n < 2; ++n) acc[a][b][m][n] = (f32x4){0.f, 0.f, 0.f, 0.f};
    bf16x8 At[4][2], B0[2][2], B1[2][2];
    const char* cA = (const char*)g.A + (size_t)cur.pm * tstep; const char* cB = (const char*)g.Bt + (size_t)cur.pn * tstep;
    PG8_STAGE(PG8_SB(0, 0), cB, voffB); PG8_STAGE(PG8_SB(0, 1), cB + hstep, voffB); PG8_STAGE(PG8_SA(0, 0), cA, voffA); PG8_STAGE(PG8_SA(0, 1), cA + hstep, voffA);
    if (wr == 1) PG8_BAR;
    PG8_WAIT_V(2); PG8_BAR;
    PG8_STAGE(PG8_SB(1, 0), cB + kstep, voffB); PG8_STAGE(PG8_SA(1, 0), cA + kstep, voffA); PG8_STAGE(PG8_SB(1, 1), cB + hstep + kstep, voffB);
    PG8_WAIT_V(6); PG8_BAR;
    for (;;) {
        const bool has_next = S.next(ui + 1, nxt);
        const char* nA = has_next ? (const char*)g.A + (size_t)nxt.pm * tstep : cA; const char* nB = has_next ? (const char*)g.Bt + (size_t)nxt.pn * tstep : cB;
        for (int t = 0; t < nt; t += 2) {
            const bool last = (t == nt - 2);
            const char* a1 = cA + (size_t)(t + 1) * kstep;
            const char* a2 = last ? nA : cA + (size_t)(t + 2) * kstep; const char* b2 = last ? nB : cB + (size_t)(t + 2) * kstep;
            const char* a3 = a2 + kstep; const char* b3 = b2 + kstep;
            PG8_LDB(B0, 0, 0); PG8_LDB(B1, 0, 1); PG8_SCHED; PG8_LDA(At, 0, 0); PG8_STAGE(PG8_SA(1, 1), a1 + hstep, voffA);
            PG8_WT; PG8_WAIT_L(0); PG8_BAR; PG8_MMA(0, 0, At, B0); PG8_MMA(0, 1, At, B1); PG8_WL; PG8_BAR; PG8_SCHED;
            PG8_LDA(At, 0, 1); PG8_STAGE(PG8_SB(0, 0), b2, voffB); PG8_STAGE(PG8_SB(0, 1), b2 + hstep, voffB); PG8_STAGE(PG8_SA(0, 0), a2, voffA);
            PG8_WT; PG8_WAIT_L(0); PG8_BAR; PG8_MMA(1, 0, At, B0); PG8_MMA(1, 1, At, B1); PG8_WL; PG8_BAR; PG8_SCHED;
            PG8_LDB(B0, 1, 0); PG8_LDB(B1, 1, 1); PG8_SCHED; PG8_LDA(At, 1, 0); PG8_STAGE(PG8_SA(0, 1), a2 + hstep, voffA);
            PG8_WT; PG8_WAIT_L(0); PG8_BAR; PG8_MMA(0, 0, At, B0); PG8_MMA(0, 1, At, B1); PG8_WL; PG8_BAR; PG8_SCHED;
            PG8_LDA(At, 1, 1); PG8_STAGE(PG8_SB(1, 0), b3, voffB); PG8_STAGE(PG8_SB(1, 1), b3 + hstep, voffB); PG8_STAGE(PG8_SA(1, 0), a3, voffA);
            PG8_WT; PG8_WAIT_L(0); PG8_BAR; PG8_MMA(1, 0, At, B0); PG8_MMA(1, 1, At, B1); PG8_WL; PG8_BAR; PG8_SCHED;
        }
        if (wr == 0) PG8_BAR;
        E(acc, cur, wr, wc, wid);
        if (!has_next) break;
#pragma unroll
        for (int a = 0; a < 2; ++a)
#pragma unroll
            for (int b = 0; b < 2; ++b)
#pragma unroll
                for (int m = 0; m < 4; ++m)
#pragma unroll
                    for (int n = 0; n < 2; ++n) acc[a][b][m][n] = (f32x4){0.f, 0.f, 0.f, 0.f};
        cur = nxt; cA = nA; cB = nB; ++ui;
        if (wr == 1) PG8_BAR;
    }
    PG8_WAIT_V(0);
    PG8_BAR;
#undef PG8_SA
#undef PG8_SB
#undef PG8_STAGE
#undef PG8_LDA
#undef PG8_LDB
#undef PG8_MMA
#undef PG8_CAT8
#undef PG8_WAIT_V
#undef PG8_WAIT_L
#undef PG8_BAR
#undef PG8_WT
#undef PG8_WL
#undef PG8_SCHED
}
}

typedef GAS unsigned gu32;
#define RLX_AGENT __ATOMIC_RELAXED, __HIP_MEMORY_SCOPE_AGENT
#define LDS_WAIT() asm volatile("s_waitcnt lgkmcnt(0)" ::: "memory")
#define VM_WAIT() asm volatile("s_waitcnt vmcnt(0)" ::: "memory")
__device__ __forceinline__ unsigned f2bf(float f) { unsigned u = __builtin_bit_cast(unsigned, f); return (u + 0x7fffu + ((u >> 16) & 1u)) >> 16; }
__device__ __forceinline__ unsigned pk2(float lo, float hi) { return f2bf(lo) | (f2bf(hi) << 16); }

#define XB_TMO      128
#define XB_XCNT(j)  (256  + 64 * (j))
#define XB_XSUB(j)  (1280 + 64 * (j))
#define XB_XGEN(j)  (2304 + 64 * (j))
#define XB_TOP      3328
#define XB_TOPGEN   3392
#define XCD_BAR_WORDS 3456
#define XB_SPIN_CAP (1u << 18)
__device__ __forceinline__ unsigned xb_ld(unsigned* p)              { return __hip_atomic_load(p, __ATOMIC_RELAXED, __HIP_MEMORY_SCOPE_AGENT); }
__device__ __forceinline__ unsigned xb_add(unsigned* p, unsigned v) { return __hip_atomic_fetch_add(p, v, __ATOMIC_RELAXED, __HIP_MEMORY_SCOPE_AGENT); }
__device__ __forceinline__ unsigned xb_xcc_id() { return (unsigned)__builtin_amdgcn_s_getreg((3 << 11) | 20) & 0xFu; }
#define XB_SPIN(cond, bar) do { unsigned _sp = 0; while (cond) { __builtin_amdgcn_s_sleep(1); \
    if ((++_sp & 255u) == 0u) { if (xb_ld(&(bar)[XB_TMO])) break; if (_sp > XB_SPIN_CAP) { atomicAdd(&(bar)[XB_TMO], 1u); break; } } } } while (0)
struct XcdBarrier { unsigned* bar; unsigned x; volatile LAS unsigned* st; };
__device__ __forceinline__ XcdBarrier xcd_barrier_post(unsigned* bar, volatile LAS unsigned* st) {
    XcdBarrier b; b.bar = bar; b.x = xb_xcc_id(); b.st = st;
    if (threadIdx.x == 0) (void)xb_add(&bar[XB_XCNT(b.x)], 1u);
    return b;
}
__device__ __forceinline__ void xcd_barrier_complete(unsigned* bar, unsigned x, unsigned& nloc, unsigned& nx) {
    const unsigned G = gridDim.x * gridDim.y * gridDim.z;
    unsigned sum, cnt, mine, sp = 0u;
    for (;;) {
        sum = 0u; cnt = 0u; mine = 0u;
#pragma unroll
        for (unsigned j = 0; j < 16; ++j) { const unsigned c = xb_ld(&bar[XB_XCNT(j)]); sum += c; cnt += (c > 0u) ? 1u : 0u; mine = (j == x) ? c : mine; }
        if (sum == G) break;
        __builtin_amdgcn_s_sleep(1);
        if ((++sp & 255u) == 0u) { if (xb_ld(&bar[XB_TMO])) break; if (sp > XB_SPIN_CAP) { atomicAdd(&bar[XB_TMO], 1u); break; } }
    }
    nloc = mine > 0u ? mine : 1u; nx = cnt > 0u ? cnt : 1u;
}
__device__ __forceinline__ void xcd_barrier(const XcdBarrier& b) {
    asm volatile("s_waitcnt vmcnt(0)" ::: "memory");
    __syncthreads();
    if (threadIdx.x == 0) {
        unsigned* bar = b.bar;
        __builtin_amdgcn_s_waitcnt(0);
        unsigned nloc = b.st[0], nx = b.st[1];
        if (nloc == 0u) { xcd_barrier_complete(bar, b.x, nloc, nx); b.st[0] = nloc; b.st[1] = nx; }
        const unsigned old = xb_add(&bar[XB_XSUB(b.x)], 1u);
        const unsigned gen = old / nloc;
        if (old + 1u == (gen + 1u) * nloc) {
            __builtin_amdgcn_fence(__ATOMIC_RELEASE, "agent");
            asm volatile("s_waitcnt vmcnt(0)" ::: "memory");
            const unsigned og = xb_add(&bar[XB_TOP], 1u);
            const unsigned tg = og / nx;
            if (og + 1u == (tg + 1u) * nx) xb_add(&bar[XB_TOPGEN], 1u);
            else XB_SPIN(xb_ld(&bar[XB_TOPGEN]) == tg, bar);
            __builtin_amdgcn_fence(__ATOMIC_ACQUIRE, "agent");
            xb_add(&bar[XB_XGEN(b.x)], 1u);
            asm volatile("s_waitcnt vmcnt(0)" ::: "memory");
        } else {
            XB_SPIN(xb_ld(&bar[XB_XGEN(b.x)]) == gen, bar);
            __builtin_amdgcn_fence(__ATOMIC_ACQUIRE, "agent");
            asm volatile("s_waitcnt vmcnt(0)" ::: "memory");
        }
    }
    __syncthreads();
}

__device__ __forceinline__ float wave_sum(float v) {
#pragma unroll
    for (int o = 1; o < 64; o <<= 1) v += __shfl_xor(v, o);
    return v;
}
__device__ __forceinline__ void p0_transpose_item(const float* W, int K, int N, bf16_t* WT, int out_row0, const float* g, LAS float* scr, int k0, int n0, int lane) {
    float v[32];
    const float* src = W + (size_t)(k0 + (lane >> 5)) * N + n0 + (lane & 31);
#pragma unroll
    for (int i = 0; i < 32; ++i) v[i] = src[(size_t)(2 * i) * N];
#pragma unroll
    for (int i = 0; i < 32; ++i) scr[(2 * i + (lane >> 5)) * 33 + (lane & 31)] = v[i];
    LDS_WAIT(); asm volatile("" ::: "memory");
    const int c = lane & 7;
    f32x4 ga = {1.f, 1.f, 1.f, 1.f}, gb = {1.f, 1.f, 1.f, 1.f};
    if (g) { ga = *(const f32x4*)(g + k0 + 8 * c); gb = *(const f32x4*)(g + k0 + 8 * c + 4); }
#pragma unroll
    for (int j = 0; j < 4; ++j) { const int n = (lane >> 3) + 8 * j; const LAS float* s = scr + (8 * c) * 33 + n;
        u32x4 o; o.x = pk2(s[0 * 33] * ga[0], s[1 * 33] * ga[1]); o.y = pk2(s[2 * 33] * ga[2], s[3 * 33] * ga[3]); o.z = pk2(s[4 * 33] * gb[0], s[5 * 33] * gb[1]); o.w = pk2(s[6 * 33] * gb[2], s[7 * 33] * gb[3]);
        *(GAS u32x4*)(WT + (size_t)(out_row0 + n) * K + k0 + 8 * c) = o; }
    LDS_WAIT(); asm volatile("" ::: "memory");
}
__device__ __forceinline__ void p0_transpose_item_fp8(const float* W, int K, int N, unsigned char* WT8, int out_row0, const float* g, float scale, LAS float* scr, int k0, int n0, int lane) {
    float v[32];
    const float* src = W + (size_t)(k0 + (lane >> 5)) * N + n0 + (lane & 31);
#pragma unroll
    for (int i = 0; i < 32; ++i) v[i] = src[(size_t)(2 * i) * N];
#pragma unroll
    for (int i = 0; i < 32; ++i) scr[(2 * i + (lane >> 5)) * 33 + (lane & 31)] = v[i];
    LDS_WAIT(); asm volatile("" ::: "memory");
    const int c = lane & 7;
    const f32x4 ga = *(const f32x4*)(g + k0 + 8 * c) * scale, gb = *(const f32x4*)(g + k0 + 8 * c + 4) * scale;
#pragma unroll
    for (int j = 0; j < 4; ++j) { const int n = (lane >> 3) + 8 * j; const LAS float* s = scr + (8 * c) * 33 + n;
        u32x2 o; o.x = pg8::pk4_fp8(s[0 * 33] * ga[0], s[1 * 33] * ga[1], s[2 * 33] * ga[2], s[3 * 33] * ga[3]); o.y = pg8::pk4_fp8(s[4 * 33] * gb[0], s[5 * 33] * gb[1], s[6 * 33] * gb[2], s[7 * 33] * gb[3]);
        *(GAS u32x2*)(WT8 + (size_t)(out_row0 + n) * K + k0 + 8 * c) = o; }
    LDS_WAIT(); asm volatile("" ::: "memory");
}
__device__ __forceinline__ void p0_transpose_item_i8(const float* W, int K, int N, unsigned char* WT8, int out_row0, const float* g, const unsigned* cmax, LAS float* scr, int k0, int n0, int lane) {
    float v[32];
    const float* src = W + (size_t)(k0 + (lane >> 5)) * N + n0 + (lane & 31);
    const int c = lane & 7;
    float cmv[4];
#pragma unroll
    for (int j = 0; j < 4; ++j) cmv[j] = __uint_as_float(cmax[n0 + (lane >> 3) + 8 * j]);
    f32x4 ga = {1.f, 1.f, 1.f, 1.f}, gb = {1.f, 1.f, 1.f, 1.f};
    if (g) { ga = *(const f32x4*)(g + k0 + 8 * c); gb = *(const f32x4*)(g + k0 + 8 * c + 4); }
#pragma unroll
    for (int i = 0; i < 32; ++i) v[i] = src[(size_t)(2 * i) * N];
#pragma unroll
    for (int i = 0; i < 32; ++i) scr[(2 * i + (lane >> 5)) * 33 + (lane & 31)] = v[i];
    LDS_WAIT(); asm volatile("" ::: "memory");
#pragma unroll
    for (int j = 0; j < 4; ++j) { const int n = (lane >> 3) + 8 * j; const LAS float* s = scr + (8 * c) * 33 + n;
        const float cm = cmv[j], inv = cm > 0.f ? 127.0f / cm : 0.f;
        u32x2 o; o.x = pg8::pk4_i8((f32x4){s[0 * 33] * ga[0], s[1 * 33] * ga[1], s[2 * 33] * ga[2], s[3 * 33] * ga[3]} * inv); o.y = pg8::pk4_i8((f32x4){s[4 * 33] * gb[0], s[5 * 33] * gb[1], s[6 * 33] * gb[2], s[7 * 33] * gb[3]} * inv);
        *(GAS u32x2*)(WT8 + (size_t)(out_row0 + n) * K + k0 + 8 * c) = o; }
    LDS_WAIT(); asm volatile("" ::: "memory");
}
__device__ __forceinline__ float wave_max(float v) {
#pragma unroll
    for (int o = 1; o < 64; o <<= 1) v = fmaxf(v, __shfl_xor(v, o));
    return v;
}
template <bool HASG>
__device__ __forceinline__ void colmax_item(const float* W, int N, int n_lo, int nb512, const float* g, unsigned* CM, int ci, int wave, int lane, LAS float* scr) {
    {
        const int kb8 = ci / nb512, nb = ci - kb8 * nb512, k0 = 256 * kb8 + 32 * wave;
        const float* src = W + (size_t)k0 * N + n_lo + 512 * nb + 4 * lane;
        float gk = 1.0f; if (HASG) gk = fabsf(g[k0 + (lane & 31)]);
        f32x4 mx0 = {0.f, 0.f, 0.f, 0.f}, mx1 = {0.f, 0.f, 0.f, 0.f};
#pragma unroll
        for (int h = 0; h < 2; ++h) {
            f32x4 v[16][2];
#pragma unroll
            for (int i = 0; i < 16; ++i) { v[i][0] = *(const f32x4*)(src + (size_t)(16 * h + i) * N); v[i][1] = *(const f32x4*)(src + (size_t)(16 * h + i) * N + 256); }
#pragma unroll
            for (int i = 0; i < 16; ++i) { f32x4 a0 = __builtin_elementwise_abs(v[i][0]), a1 = __builtin_elementwise_abs(v[i][1]);
                if (HASG) { const float gi = __builtin_bit_cast(float, __builtin_amdgcn_readlane(__builtin_bit_cast(int, gk), 16 * h + i)); a0 = a0 * gi; a1 = a1 * gi; }
                mx0 = __builtin_elementwise_max(mx0, a0); mx1 = __builtin_elementwise_max(mx1, a1); }
        }
        *(LAS f32x4*)&scr[wave * 512 + 4 * lane] = mx0; *(LAS f32x4*)&scr[wave * 512 + 256 + 4 * lane] = mx1;
        __syncthreads();
        { const int t = wave * 64 + lane; float m = scr[t];
#pragma unroll
          for (int w = 1; w < 8; ++w) m = fmaxf(m, scr[w * 512 + t]);
          (void)__hip_atomic_fetch_max(CM + n_lo + 512 * nb + t, __float_as_uint(m), __ATOMIC_RELAXED, __HIP_MEMORY_SCOPE_AGENT); }
        __syncthreads();
    }
}
__device__ __forceinline__ void p0_load_tile(const float* W, int N, int k0, int n0, int lane, float (&v)[32]) {
    const float* src = W + (size_t)(k0 + (lane >> 5)) * N + n0 + (lane & 31);
#pragma unroll
    for (int i = 0; i < 32; ++i) v[i] = src[(size_t)(2 * i) * N];
}
__device__ __forceinline__ void p0_finish_bf16(const float (&v)[32], int K, bf16_t* WT, int out_row0, const float* g, LAS float* scr, int k0, int lane) {
#pragma unroll
    for (int i = 0; i < 32; ++i) scr[(2 * i + (lane >> 5)) * 33 + (lane & 31)] = v[i];
    LDS_WAIT(); asm volatile("" ::: "memory");
    const int c = lane & 7;
    f32x4 ga = {1.f, 1.f, 1.f, 1.f}, gb = {1.f, 1.f, 1.f, 1.f};
    if (g) { ga = *(const f32x4*)(g + k0 + 8 * c); gb = *(const f32x4*)(g + k0 + 8 * c + 4); }
#pragma unroll
    for (int j = 0; j < 4; ++j) { const int n = (lane >> 3) + 8 * j; const LAS float* s = scr + (8 * c) * 33 + n;
        u32x4 o; o.x = pk2(s[0 * 33] * ga[0], s[1 * 33] * ga[1]); o.y = pk2(s[2 * 33] * ga[2], s[3 * 33] * ga[3]); o.z = pk2(s[4 * 33] * gb[0], s[5 * 33] * gb[1]); o.w = pk2(s[6 * 33] * gb[2], s[7 * 33] * gb[3]);
        *(GAS u32x4*)(WT + (size_t)(out_row0 + n) * K + k0 + 8 * c) = o; }
    LDS_WAIT(); asm volatile("" ::: "memory");
}
__device__ __forceinline__ void p0_finish_i8(const float (&v)[32], int K, unsigned char* WT8, int out_row0, const float* g, const unsigned* cmax, int n0, LAS float* scr, int k0, int lane) {
    const int c = lane & 7;
    float cmv[4];
#pragma unroll
    for (int j = 0; j < 4; ++j) cmv[j] = __uint_as_float(cmax[n0 + (lane >> 3) + 8 * j]);
    f32x4 ga = {1.f, 1.f, 1.f, 1.f}, gb = {1.f, 1.f, 1.f, 1.f};
    if (g) { ga = *(const f32x4*)(g + k0 + 8 * c); gb = *(const f32x4*)(g + k0 + 8 * c + 4); }
#pragma unroll
    for (int i = 0; i < 32; ++i) scr[(2 * i + (lane >> 5)) * 33 + (lane & 31)] = v[i];
    LDS_WAIT(); asm volatile("" ::: "memory");
#pragma unroll
    for (int j = 0; j < 4; ++j) { const int n = (lane >> 3) + 8 * j; const LAS float* s = scr + (8 * c) * 33 + n;
        const float cm = cmv[j], inv = cm > 0.f ? 127.0f / cm : 0.f;
        u32x2 o; o.x = pg8::pk4_i8((f32x4){s[0 * 33] * ga[0], s[1 * 33] * ga[1], s[2 * 33] * ga[2], s[3 * 33] * ga[3]} * inv); o.y = pg8::pk4_i8((f32x4){s[4 * 33] * gb[0], s[5 * 33] * gb[1], s[6 * 33] * gb[2], s[7 * 33] * gb[3]} * inv);
        *(GAS u32x2*)(WT8 + (size_t)(out_row0 + n) * K + k0 + 8 * c) = o; }
    LDS_WAIT(); asm volatile("" ::: "memory");
}
template <class Fin>
__device__ __forceinline__ void p0_pipe(const float* W, int N, int nblk, int nitems, int gw, int NGW, int lane, const Fin& fin) {
    float va[32], vb[32];
#pragma unroll
    for (int i = 0; i < 32; ++i) vb[i] = 0.f;
    int it = gw;
    if (it < nitems) { const int kb = it / nblk, nb = it - kb * nblk; p0_load_tile(W, N, 64 * kb, 32 * nb, lane, va); }
    for (; it < nitems; it += NGW) {
        const int nx = it + NGW;
        if (nx < nitems) { const int kb = nx / nblk, nb = nx - kb * nblk; p0_load_tile(W, N, 64 * kb, 32 * nb, lane, vb); }
        { const int kb = it / nblk, nb = it - kb * nblk; fin(va, 64 * kb, 32 * nb); }
#pragma unroll
        for (int i = 0; i < 32; ++i) va[i] = vb[i];
    }
}
__device__ __forceinline__ void p0_matrix(const float* W, int K, int N, bf16_t* WT, const float* g, bool upmap, LAS float* scr, int gw, int NGW, int lane) {
    const int nblk = N / 32, nitems = (K / 64) * nblk;
    for (int it = gw; it < nitems; it += NGW) {
        const int kb = it / nblk, nb = it - kb * nblk, n0 = 32 * nb;
        int orow = n0;
        if (upmap) orow = (n0 < DFF) ? 256 * (n0 >> 7) + (n0 & 127) : 256 * ((n0 - DFF) >> 7) + 128 + ((n0 - DFF) & 127);
        p0_transpose_item(W, K, N, WT, orow, g, scr, 64 * kb, n0, lane);
    }
}

__device__ __forceinline__ void row_to_i8(const bf16_t* X, unsigned char* A8, float* RS, int m, int lane) {
    const u32x4* src = (const u32x4*)(X + (size_t)m * DM) + lane;
    u32x4 w[8]; float mx = 0.f, ss = 0.f;
#pragma unroll
    for (int j = 0; j < 8; ++j) w[j] = src[64 * j];
#pragma unroll
    for (int j = 0; j < 8; ++j) { f32x4 a, b; pg8::bf8_to_f32(w[j], a, b); ss += pg8::sumsq4(a) + pg8::sumsq4(b);
        const f32x4 ab = __builtin_elementwise_max(__builtin_elementwise_abs(a), __builtin_elementwise_abs(b)); mx = fmaxf(mx, fmaxf(fmaxf(ab[0], ab[1]), fmaxf(ab[2], ab[3]))); }
    mx = wave_max(mx); ss = wave_sum(ss);
    const float inv = mx > 0.f ? 127.0f / mx : 0.f;
    u32x2* dst = (u32x2*)(A8 + (size_t)m * DM) + lane;
#pragma unroll
    for (int j = 0; j < 8; ++j) { f32x4 a, b; pg8::bf8_to_f32(w[j], a, b); u32x2 o; o.x = pg8::pk4_i8(a * inv); o.y = pg8::pk4_i8(b * inv); dst[64 * j] = o; }
    if (lane == 0) RS[m] = rsqrtf(ss * (1.0f / DM) + EPS) * mx * (1.0f / 127.0f);
}

__device__ __forceinline__ unsigned offb(unsigned row, unsigned ch) { return 256u * row + 16u * (ch ^ (((row & 3u) << 2) | ((row >> 2) & 3u))); }
__device__ __forceinline__ s16x4 vtr(const LAS unsigned char* p) { return __builtin_bit_cast(s16x4, __builtin_amdgcn_ds_read_tr16_b64_v4i16((LAS s16x4*)p)); }
#define MFMA16(a, b, c) __builtin_amdgcn_mfma_f32_16x16x32_bf16(a, b, c, 0, 0, 0)
__device__ __forceinline__ void lds_read8_b128(bf16x8 (&k)[8], const unsigned (&a)[8]) {
    asm volatile("ds_read_b128 %0, %8\n\tds_read_b128 %1, %9\n\tds_read_b128 %2, %10\n\tds_read_b128 %3, %11\n\tds_read_b128 %4, %12\n\tds_read_b128 %5, %13\n\tds_read_b128 %6, %14\n\tds_read_b128 %7, %15\n\ts_waitcnt lgkmcnt(0)"
                 : "=&v"(k[0]), "=&v"(k[1]), "=&v"(k[2]), "=&v"(k[3]), "=&v"(k[4]), "=&v"(k[5]), "=&v"(k[6]), "=&v"(k[7])
                 : "v"(a[0]), "v"(a[1]), "v"(a[2]), "v"(a[3]), "v"(a[4]), "v"(a[5]), "v"(a[6]), "v"(a[7]) : "memory");
}
__device__ __forceinline__ void lds_read8_tr(s16x4 (&v)[8], const unsigned (&a)[8]) {
    asm volatile("ds_read_b64_tr_b16 %0, %8\n\tds_read_b64_tr_b16 %1, %9\n\tds_read_b64_tr_b16 %2, %10\n\tds_read_b64_tr_b16 %3, %11\n\tds_read_b64_tr_b16 %4, %12\n\tds_read_b64_tr_b16 %5, %13\n\tds_read_b64_tr_b16 %6, %14\n\tds_read_b64_tr_b16 %7, %15\n\ts_waitcnt lgkmcnt(0)"
                 : "=&v"(v[0]), "=&v"(v[1]), "=&v"(v[2]), "=&v"(v[3]), "=&v"(v[4]), "=&v"(v[5]), "=&v"(v[6]), "=&v"(v[7])
                 : "v"(a[0]), "v"(a[1]), "v"(a[2]), "v"(a[3]), "v"(a[4]), "v"(a[5]), "v"(a[6]), "v"(a[7]) : "memory");
}

__device__ __forceinline__ void gate_phase(LAS unsigned char* lds, const bf16_t* U, const bf16_t* VSN, const bf16_t* WS, const float* bs, const float* ga, bf16_t* mix, int vcu, int G, const int w) {
    const int lane = lane_id(), tid = w * 64 + lane, i16 = lane & 15, g = lane >> 4, q = i16 >> 2, p = i16 & 3;
    unsigned ldsw[4], goff[4];
#pragma unroll
    for (int i = 0; i < 4; ++i) { const int c = tid + 512 * i, tok = c >> 4, ch = c & 15; ldsw[i] = offb(tok, ch); goff[i] = tok * DG + ch * 8; }
    unsigned va[2][8];
#pragma unroll
    for (int t = 0; t < 2; ++t)
#pragma unroll
        for (int c = 0; c < 8; ++c) va[t][c] = offb(8 * g + 4 * t + q, 2 * c + (p >> 1)) + 8 * (p & 1);
    const int NU = 128 * 16;
    u32x4 st[4];
    int it = vcu;
    if (it < NU) {
        const bf16_t* src = VSN + (size_t)((it >> 4) * 128) * DG + (it & 15) * HD;
#pragma unroll
        for (int i = 0; i < 4; ++i) st[i] = *(const u32x4*)(src + goff[i]);
    }
    int par = 0;
    for (; it < NU; it += G, par ^= 1) {
        const int cidx = it >> 4, h = it & 15;
        LAS unsigned char* buf = lds + par * 32768;
#pragma unroll
        for (int i = 0; i < 4; ++i) *(LAS u32x4*)(buf + ldsw[i]) = st[i];
        LDS_WAIT(); __builtin_amdgcn_s_barrier(); asm volatile("" ::: "memory");
        const int nit = it + G;
        if (nit < NU) {
            const bf16_t* src = VSN + (size_t)((nit >> 4) * 128) * DG + (nit & 15) * HD;
#pragma unroll
            for (int i = 0; i < 4; ++i) st[i] = *(const u32x4*)(src + goff[i]);
        }
        bf16x8 wf[4];
        const bf16_t* wsp = WS + ((size_t)h * 128 + 16 * w + i16) * 128 + 8 * g;
#pragma unroll
        for (int ks = 0; ks < 4; ++ks) wf[ks] = *(const bf16x8*)(wsp + 32 * ks);
        f32x4 acc[8];
#pragma unroll
        for (int c = 0; c < 8; ++c) acc[c] = (f32x4){0.f, 0.f, 0.f, 0.f};
#pragma unroll
        for (int ks = 0; ks < 4; ++ks)
#pragma unroll
            for (int c = 0; c < 8; ++c) {
                const s16x4 lo = vtr(buf + va[0][c] + ks * 8192), hi = vtr(buf + va[1][c] + ks * 8192);
                const bf16x8 vf = {lo[0], lo[1], lo[2], lo[3], hi[0], hi[1], hi[2], hi[3]};
                acc[c] = MFMA16(vf, wf[ks], acc[c]);
            }
        const int tok = cidx * 128 + 16 * w + i16;
        const float bias = bs[h * 128 + 16 * w + i16];
        const bf16_t* up = U + (size_t)tok * DG + h * HD + 4 * g;
        float ss = 0.f;
#pragma unroll
        for (int c = 0; c < 8; ++c) {
            const u32x2 uw = *(const u32x2*)(up + 16 * c);
            f32x4 uv; uv[0] = __uint_as_float(uw.x << 16); uv[1] = __uint_as_float(uw.x & 0xffff0000u); uv[2] = __uint_as_float(uw.y << 16); uv[3] = __uint_as_float(uw.y & 0xffff0000u);
            acc[c] = uv * (acc[c] + bias); ss += pg8::sumsq4(acc[c]);
        }
        ss = pg8::xsum_fq(ss);
        const float rr = rsqrtf(ss * (1.0f / 128.0f) + EPS);
        bf16_t* op = mix + (size_t)tok * DM + h * HD + 4 * g;
        const float* gp = ga + h * HD + 4 * g;
        f32x4 gvv[8];
#pragma unroll
        for (int c = 0; c < 8; ++c) gvv[c] = *(const f32x4*)(gp + 16 * c);
#pragma unroll
        for (int k2 = 0; k2 < 4; ++k2) {
            const f32x4 y0 = acc[2 * k2] * rr * gvv[2 * k2], y1 = acc[2 * k2 + 1] * rr * gvv[2 * k2 + 1];
            const u32x2 s0 = __builtin_amdgcn_permlane16_swap(pg8::cvt_pk_bf16(y0[0], y0[1]), pg8::cvt_pk_bf16(y1[0], y1[1]), false, false);
            const u32x2 s1 = __builtin_amdgcn_permlane16_swap(pg8::cvt_pk_bf16(y0[2], y0[3]), pg8::cvt_pk_bf16(y1[2], y1[3]), false, false);
            u32x4 o; o.x = s0.x; o.y = s1.x; o.z = s0.y; o.w = s1.y;
            *(u32x4*)(op - 4 * g + 16 * (2 * k2 + (g & 1)) + 4 * (g & 2)) = o;
        }
    }
    LDS_WAIT(); __builtin_amdgcn_s_barrier(); asm volatile("" ::: "memory");
}

__device__ __forceinline__ void na_phase(LAS unsigned char* lds, LAS float* rpbL, const bf16_t* Q, const bf16_t* Kt, const bf16_t* Vt, const float* rpb, const float* gb, bf16_t* mix, int vcu, int G, const int w) {
    const int lane = lane_id(), tid = w * 64 + lane, hh = w >> 2, cb = w & 3, i16 = lane & 15, g = lane >> 4, q = i16 >> 2, p = i16 & 3;
    const int kb = (16 * cb - 8) < 0 ? 0 : ((16 * cb - 8) > 32 ? 32 : (16 * cb - 8));
    unsigned goff[4];
#pragma unroll
    for (int i = 0; i < 4; ++i) { const unsigned o = (unsigned)((w * 4 + i) * 1024 + lane * 16), hd = o >> 14, o2 = o & 16383u, row = o2 >> 8, sp = (o2 >> 4) & 15u;
        const unsigned ch = sp ^ (((row & 3u) << 2) | ((row >> 2) & 3u)); goff[i] = row * DG + hd * 128 + ch * 8; }
    unsigned ka[2][4], va[2][8];
#pragma unroll
    for (int t = 0; t < 2; ++t) {
#pragma unroll
        for (int s = 0; s < 4; ++s) ka[t][s] = hh * 16384 + offb(kb + 8 * q + 4 * t + p, 4 * s + g);
#pragma unroll
        for (int c = 0; c < 8; ++c) va[t][c] = hh * 16384 + offb(kb + 8 * g + 4 * t + q, 2 * c + (p >> 1)) + 8 * (p & 1);
    }
    const int qc = 16 * cb + i16, cs = (qc - 8) < 0 ? 0 : ((qc - 8) > 48 ? 48 : (qc - 8));
    bool valid[2][4];
#pragma unroll
    for (int t = 0; t < 2; ++t)
#pragma unroll
        for (int e = 0; e < 4; ++e) { const int kc = kb + 8 * g + 4 * t + e; valid[t][e] = (kc >= cs) && (kc < cs + 16); }
    const int NI = 2 * 128 * 8;
    const float SC = 0.08838834764831845f * LOG2E;
#define NA_ISSUE(slot, src) do { _Pragma("unroll") for (int _i = 0; _i < 4; ++_i) \
        __builtin_amdgcn_global_load_lds((const unsigned*)((src) + goff[_i]), (LAS unsigned*)(lds + (slot) * 32768 + (w * 4 + _i) * 1024), 16, 0, 0); } while (0)
    int it = vcu;
    if (it < NI) {
        const int b = it >> 10, r = (it >> 3) & 127, hp = it & 7, rs = (r - 4) < 0 ? 0 : ((r - 4) > 120 ? 120 : (r - 4));
        const bf16_t* src = Kt + (size_t)(b * SEQ + rs * 64) * DG + hp * 256;
        NA_ISSUE(0, src); NA_ISSUE(1, src + (size_t)64 * DG); NA_ISSUE(2, src + (size_t)128 * DG);
    }
    int rpb_hp = -1;
    for (; it < NI; it += G) {
        const int b = it >> 10, r = (it >> 3) & 127, hp = it & 7, rs = (r - 4) < 0 ? 0 : ((r - 4) > 120 ? 120 : (r - 4));
        const int head = 2 * hp + hh;
        if (hp != rpb_hp) {
            for (int e = tid; e < 2 * 720; e += 512) { const int hd = e / 720, rem = e - hd * 720, dr = rem / 48, x = rem - dr * 48, dc = x - 8;
                rpbL[e] = (dc >= 0 && dc < 31) ? rpb[((2 * hp + hd) * 15 + dr) * 31 + dc] * LOG2E : 0.f; }
            if (tid < 256) rpbL[1440 + tid] = gb[(2 * hp) * HD + tid];
            rpb_hp = hp;
        }
        const size_t tq = (size_t)b * SEQ + r * 64 + qc;
        bf16x8 qf[4];
        { const bf16_t* qp = Q + tq * DG + head * HD + 8 * g;
#pragma unroll
          for (int s = 0; s < 4; ++s) qf[s] = *(const bf16x8*)(qp + 32 * s); }
        const bf16_t* kbase = Kt + (size_t)(b * SEQ + rs * 64) * DG + hp * 256;
        const bf16_t* vbase = Vt + (size_t)(b * SEQ + rs * 64) * DG + hp * 256;
        const int nit = it + G;
        const bf16_t* nsrc = kbase;
        if (nit < NI) { const int nb = nit >> 10, nr = (nit >> 3) & 127, nhp = nit & 7, nrs = (nr - 4) < 0 ? 0 : ((nr - 4) > 120 ? 120 : (nr - 4));
            nsrc = Kt + (size_t)(nb * SEQ + nrs * 64) * DG + nhp * 256; }
        f32x4 S[8][2];
        f32x4 O[8];
        bf16x8 pf[8];
        float inv_l = 0.f;
#pragma unroll
        for (int c = 0; c < 8; ++c) O[c] = (f32x4){0.f, 0.f, 0.f, 0.f};
#pragma unroll
        for (int sg = 0; sg < 16; ++sg) {
            LAS unsigned char* buf = lds + (sg & 3) * 32768;
            asm volatile("s_waitcnt vmcnt(8)" ::: "memory"); __builtin_amdgcn_s_barrier(); asm volatile("" ::: "memory");
            {
                const int t3 = sg + 3;
                const bf16_t* src = (t3 < 8) ? kbase + (size_t)(t3 * 64) * DG : ((t3 < 16) ? vbase + (size_t)((t3 - 8) * 64) * DG : nsrc + (size_t)((t3 - 16) * 64) * DG);
                NA_ISSUE(t3 & 3, src);
            }
            const unsigned sb = (unsigned)(size_t)buf;
            if (sg < 8) {
                bf16x8 kf[8]; unsigned ad[8];
#pragma unroll
                for (int t = 0; t < 2; ++t)
#pragma unroll
                    for (int s = 0; s < 4; ++s) ad[t * 4 + s] = sb + ka[t][s];
                lds_read8_b128(kf, ad);
#pragma unroll
                for (int t = 0; t < 2; ++t) {
                    f32x4 a = {0.f, 0.f, 0.f, 0.f};
#pragma unroll
                    for (int s = 0; s < 4; ++s) a = MFMA16(kf[t * 4 + s], qf[s], a);
                    S[sg & 7][t] = a;
                }
                if (sg == 7) {
                    const int rb = hh * 720 + (rs - r + 7) * 48 + (kb + 8 * g - qc + 23);
                    float mx = -3.0e38f;
#pragma unroll
                    for (int i = 0; i < 8; ++i)
#pragma unroll
                        for (int t = 0; t < 2; ++t)
#pragma unroll
                            for (int e = 0; e < 4; ++e) {
                                const float sv = valid[t][e] ? (S[i][t][e] * SC + rpbL[rb + i * 48 + 4 * t + e]) : -3.0e38f;
                                S[i][t][e] = sv; mx = fmaxf(mx, sv);
                            }
                    mx = fmaxf(mx, __shfl_xor(mx, 16)); mx = fmaxf(mx, __shfl_xor(mx, 32));
                    float l = 0.f;
#pragma unroll
                    for (int i = 0; i < 8; ++i) {
#pragma unroll
                        for (int t = 0; t < 2; ++t)
#pragma unroll
                            for (int e = 0; e < 4; ++e) { const float pe = __builtin_amdgcn_exp2f(S[i][t][e] - mx); S[i][t][e] = pe; l += pe; }
                        u32x4 pw; pw.x = pg8::cvt_pk_bf16(S[i][0][0], S[i][0][1]); pw.y = pg8::cvt_pk_bf16(S[i][0][2], S[i][0][3]);
                        pw.z = pg8::cvt_pk_bf16(S[i][1][0], S[i][1][1]); pw.w = pg8::cvt_pk_bf16(S[i][1][2], S[i][1][3]);
                        pf[i] = __builtin_bit_cast(bf16x8, pw);
                    }
                    l = pg8::xsum_fq(l);
                    inv_l = 1.0f / l;
                }
            } else {
#pragma unroll
                for (int hc = 0; hc < 2; ++hc) {
                    s16x4 lo[8], hi[8]; unsigned ad[8];
#pragma unroll
                    for (int c = 0; c < 4; ++c) { ad[c] = sb + va[0][hc * 4 + c]; ad[4 + c] = sb + va[1][hc * 4 + c]; }
                    { s16x4 tv[8]; lds_read8_tr(tv, ad);
#pragma unroll
                      for (int c = 0; c < 4; ++c) { lo[c] = tv[c]; hi[c] = tv[4 + c]; } }
#pragma unroll
                    for (int c = 0; c < 4; ++c) {
                        const bf16x8 vf = {lo[c][0], lo[c][1], lo[c][2], lo[c][3], hi[c][0], hi[c][1], hi[c][2], hi[c][3]};
                        O[hc * 4 + c] = MFMA16(vf, pf[sg & 7], O[hc * 4 + c]);
                    }
                }
            }
        }
        float ss = 0.f;
#pragma unroll
        for (int c = 0; c < 8; ++c) { O[c] = O[c] * inv_l; ss += pg8::sumsq4(O[c]); }
        ss = pg8::xsum_fq(ss);
        const float rr = rsqrtf(ss * (1.0f / 128.0f) + EPS);
        bf16_t* op = mix + tq * DM + DG + head * HD + 4 * g;
        const LAS float* gp = rpbL + 1440 + hh * HD + 4 * g;
        f32x4 gvv[8];
#pragma unroll
        for (int c = 0; c < 8; ++c) gvv[c] = *(const LAS f32x4*)(gp + 16 * c);
#pragma unroll
        for (int k2 = 0; k2 < 4; ++k2) {
            const f32x4 y0 = O[2 * k2] * rr * gvv[2 * k2], y1 = O[2 * k2 + 1] * rr * gvv[2 * k2 + 1];
            const u32x2 s0 = __builtin_amdgcn_permlane16_swap(pg8::cvt_pk_bf16(y0[0], y0[1]), pg8::cvt_pk_bf16(y1[0], y1[1]), false, false);
            const u32x2 s1 = __builtin_amdgcn_permlane16_swap(pg8::cvt_pk_bf16(y0[2], y0[3]), pg8::cvt_pk_bf16(y1[2], y1[3]), false, false);
            u32x4 o; o.x = s0.x; o.y = s1.x; o.z = s0.y; o.w = s1.y;
            *(u32x4*)(op - 4 * g + 16 * (2 * k2 + (g & 1)) + 4 * (g & 2)) = o;
        }
    }
#undef NA_ISSUE
    asm volatile("s_waitcnt vmcnt(0)" ::: "memory"); LDS_WAIT(); __builtin_amdgcn_s_barrier(); asm volatile("" ::: "memory");
}

struct Args { const float* in[22]; float* out; unsigned char* ws; int ph_lo, ph_hi; };
static_assert(sizeof(Args) == 22 * 8 + 8 + 8 + 8, "Args has no padding");

__global__ void __launch_bounds__(512, 2) mk_fwd(Args args) {
    extern __shared__ __attribute__((aligned(16))) unsigned char lds_raw[];
    LAS unsigned char* lds = (LAS unsigned char*)lds_raw;
    volatile LAS unsigned* MISC = (volatile LAS unsigned*)(lds + MISC_OFF);
    const int wave = __builtin_amdgcn_readfirstlane(threadIdx.x >> 6);
    const int G = gridDim.x; const int bx = blockIdx.x; const int vcu = (G % 8 == 0) ? (bx % 8) * (G / 8) + bx / 8 : bx;
    unsigned char* ws = args.ws;
    unsigned* ctl = (unsigned*)(ws + WS_CTL);
    for (int u = threadIdx.x; u < (LDS_BYTES - MISC_OFF) / 4; u += 512) ((LAS unsigned*)(lds + MISC_OFF))[u] = 0u;
    __syncthreads();
    XcdBarrier bar; bar.bar = ctl + CW_BAR; bar.x = 0; bar.st = nullptr;
    if (MK_N_LAUNCHES == 1) bar = xcd_barrier_post(ctl + CW_BAR, MISC + 8);
    const int lo = args.ph_lo, hi = args.ph_hi;
#define IN(k) (lo <= (k) && (k) < hi)
#define BOTH(k) (IN(k) && IN((k) + 1))
#define GRID_BAR() do { if (MK_N_LAUNCHES == 1) xcd_barrier(bar); } while (0)

    const float* x = args.in[0]; const float* pin = args.in[1]; const float* g_mix = args.in[2]; const float* w_in = args.in[3];
    const float* g_v = args.in[4]; const float* gws = args.in[5]; const float* gbs = args.in[6]; const float* g_q = args.in[7]; const float* g_k = args.in[8];
    const float* rpb = args.in[9]; const float* g_oa = args.in[10]; const float* g_ob = args.in[11]; const float* w_out = args.in[12]; const float* g_ffn = args.in[13];
    const float* w_up = args.in[14]; const float* conv_w = args.in[15]; const float* conv_b = args.in[16]; const float* w_down = args.in[17]; const float* g_ple = args.in[18];
    const float* w_g = args.in[19]; const float* w_p = args.in[20]; const float* g_post = args.in[21];
    float* out = args.out;
    bf16_t* WinT = (bf16_t*)(ws + WS_WIN); bf16_t* WoutT = (bf16_t*)(ws + WS_WOUT); bf16_t* WupT = (bf16_t*)(ws + WS_WUP); bf16_t* WdnT = (bf16_t*)(ws + WS_WDN);
    bf16_t* WgT = (bf16_t*)(ws + WS_WG); bf16_t* WpT = (bf16_t*)(ws + WS_WP); bf16_t* WSb = (bf16_t*)(ws + WS_WS); bf16_t* PB = (bf16_t*)(ws + WS_PB);
    bf16_t* XA = (bf16_t*)(ws + WS_XA); bf16_t* EB = (bf16_t*)(ws + WS_E); bf16_t* Z = (bf16_t*)(ws + WS_Z); bf16_t* MIX = (bf16_t*)(ws + WS_MIX); bf16_t* ACT = (bf16_t*)(ws + WS_ACT);
    unsigned* CMAX2 = (unsigned*)(ws + WS_CMAX2); float* RSN = (float*)(ws + WS_RSN); unsigned char* WIN8 = ws + WS_WIN8;
    unsigned* CMAXG = (unsigned*)(ws + WS_CMAXG); float* RSB = (float*)(ws + WS_RSB);
    unsigned* CMAX = (unsigned*)(ws + WS_CMAX); float* RSF = (float*)(ws + WS_RSF); unsigned char* A8H = ws + WS_A8H;
    float* STA = (float*)(ws + WS_STA); float* STB = (float*)(ws + WS_STB); float* STE = (float*)(ws + WS_STE); float* EDGE = (float*)(ws + WS_EDGE);
    LAS float* epiP = (LAS float*)(lds + EPI_P); LAS f32x4* epiH = (LAS f32x4*)(lds + EPI_H); LAS float* epiRS = (LAS float*)(lds + EPI_RS);

    if (IN(0)) {
        const int lane = lane_id(), gw = vcu * 8 + wave, NGW = G * 8;
        constexpr int NI_UP = (DM / 256) * (DUP / 512), NI_IN = (DM / 256) * ((I8_R1 - I8_R0) / 512), NI_G = (DM / 256) * (DM / 512);
        for (int ci = vcu; ci < NI_UP + NI_IN + NI_G; ci += G) {
            if (ci < NI_UP) colmax_item<true>(w_up, DUP, 0, DUP / 512, g_ffn, CMAX, ci, wave, lane, (LAS float*)lds);
            else if (ci < NI_UP + NI_IN) colmax_item<false>(w_in, DIN, I8_R0, (I8_R1 - I8_R0) / 512, nullptr, CMAX2, ci - NI_UP, wave, lane, (LAS float*)lds);
            else colmax_item<true>(w_g, DM, 0, DM / 512, g_ple, CMAXG, ci - NI_UP - NI_IN, wave, lane, (LAS float*)lds);
        }
        if (BOTH(0)) GRID_BAR();
    }
    if (IN(1)) {
      for (int rep0 = 0; rep0 < REP0; ++rep0) {
        LAS float* scr = (LAS float*)(lds + wave * 16384);
        const int lane = lane_id(), tid = wave * 64 + lane;
        const int gw = vcu * 8 + wave, NGW = G * 8;
        p0_pipe(w_in, DIN, DIN / 32, (DM / 64) * (DIN / 32), gw, NGW, lane, [&](const float (&v)[32], int k0, int n0) {
            if (n0 >= I8_R0 && n0 < I8_R1) p0_finish_i8(v, DM, WIN8, n0, nullptr, CMAX2, n0, scr, k0, lane);
            else p0_finish_bf16(v, DM, WinT, n0, nullptr, scr, k0, lane); });
        p0_pipe(w_out, DM, DM / 32, (DM / 64) * (DM / 32), gw, NGW, lane, [&](const float (&v)[32], int k0, int n0) { p0_finish_bf16(v, DM, WoutT, n0, nullptr, scr, k0, lane); });
        p0_pipe(w_up, DUP, DUP / 32, (DM / 64) * (DUP / 32), gw, NGW, lane, [&](const float (&v)[32], int k0, int n0) {
            const int orow = (n0 < DFF) ? 256 * (n0 >> 7) + (n0 & 127) : 256 * ((n0 - DFF) >> 7) + 128 + ((n0 - DFF) & 127);
            p0_finish_i8(v, DM, (unsigned char*)WupT, orow, g_ffn, CMAX, n0, scr, k0, lane); });
        p0_pipe(w_down, DM, DM / 32, (DFF / 64) * (DM / 32), gw, NGW, lane, [&](const float (&v)[32], int k0, int n0) { p0_finish_bf16(v, DFF, WdnT, n0, nullptr, scr, k0, lane); });
        p0_pipe(w_g, DM, DM / 32, (DM / 64) * (DM / 32), gw, NGW, lane, [&](const float (&v)[32], int k0, int n0) { p0_finish_i8(v, DM, (unsigned char*)WgT, n0, g_ple, CMAXG, n0, scr, k0, lane); });
        p0_pipe(w_p, DM, DM / 32, (DPLE / 64) * (DM / 32), gw, NGW, lane, [&](const float (&v)[32], int k0, int n0) { p0_finish_bf16(v, DPLE, WpT, n0, nullptr, scr, k0, lane); });
        for (int m = gw; m < M; m += NGW) {
            const f32x4* xr = (const f32x4*)(x + (size_t)m * DM) + lane;
            f32x4 v[16]; float s = 0.f;
#pragma unroll
            for (int j = 0; j < 16; ++j) { v[j] = xr[64 * j]; s += pg8::sumsq4(v[j]); }
            const float r = rsqrtf(wave_sum(s) * (1.0f / DM) + EPS);
            u32x2* o8 = (u32x2*)(XA + (size_t)m * DM) + lane;
            float mx = 0.f;
#pragma unroll
            for (int j = 0; j < 16; ++j) { const f32x4 gg = *((const f32x4*)g_mix + lane + 64 * j); const f32x4 y = v[j] * r * gg; v[j] = y; u32x2 o; o.x = pk2(y[0], y[1]); o.y = pk2(y[2], y[3]); o8[64 * j] = o;
                const f32x4 ay = __builtin_elementwise_abs(y); mx = fmaxf(mx, fmaxf(fmaxf(ay[0], ay[1]), fmaxf(ay[2], ay[3]))); }
            mx = wave_max(mx);
            const float inv = mx > 0.f ? 127.0f / mx : 0.f;
            unsigned* o4 = (unsigned*)(A8H + (size_t)m * DM) + lane;
#pragma unroll
            for (int j = 0; j < 16; ++j) o4[64 * j] = pg8::pk4_i8(v[j] * inv);
            if (lane == 0) RSN[m] = mx * (1.0f / 127.0f);
        }
        const int gt = vcu * 512 + tid, NGT = G * 512;
        for (int i0 = gt; i0 < M * DPLE / 4; i0 += 8 * NGT) {
            f32x4 pv[8];
#pragma unroll
            for (int q = 0; q < 8; ++q) { const int i = i0 + q * NGT; pv[q] = (i < M * DPLE / 4) ? ((const f32x4*)pin)[i] : (f32x4){0.f, 0.f, 0.f, 0.f}; }
#pragma unroll
            for (int q = 0; q < 8; ++q) { const int i = i0 + q * NGT; if (i < M * DPLE / 4) { u32x2 o; o.x = pk2(pv[q][0], pv[q][1]); o.y = pk2(pv[q][2], pv[q][3]); ((u32x2*)PB)[i] = o; } }
        }
        for (int i = gt; i < NH * 128 * 128 / 4; i += NGT) { const f32x4 v = ((const f32x4*)gws)[i]; u32x2 o; o.x = pk2(v[0], v[1]); o.y = pk2(v[2], v[3]); ((u32x2*)WSb)[i] = o; }
        if (REP0 > 1) __syncthreads();
      }
        if (BOTH(1)) GRID_BAR();
    }
    if (IN(2)) {
        { pg8::Gemm gm{(const bf16_t*)A8H, (const bf16_t*)WIN8, M, DIN, DM / 2}; pg8::MapOrder S; S.init(M, I8_R1 - I8_R0, G, bx); S.lo_n = 0; S.gap = I8_R0 / 256;
          int rs_pm = -1;
          pg8::EpiZ<true> E{Z, g_v, g_q, g_k, epiP, RSN, CMAX2, epiRS, &rs_pm};
          pg8::gemm_phase<pg8::EpiZ<true>, pg8::MapOrder, false, 2>(lds, gm, S, E, wave); }
        { pg8::Gemm gm{XA, WinT, M, DIN, DM}; pg8::MapOrder S; S.init(M, DIN - (I8_R1 - I8_R0), G, bx); S.lo_n = I8_R0 / 256; S.gap = (I8_R1 - I8_R0) / 256;
          pg8::EpiZ<false> E{Z, g_v, g_q, g_k, epiP, nullptr, nullptr, nullptr, nullptr};
          pg8::gemm_phase<pg8::EpiZ<false>, pg8::MapOrder>(lds, gm, S, E, wave); }
        if (BOTH(2)) GRID_BAR();
    }
    if (IN(3)) {
      for (int rep2 = 0; rep2 < REP2; ++rep2) {
        gate_phase(lds, Z, Z + (size_t)1 * M * DG, WSb, gbs, g_oa, MIX, vcu, G, wave);
        na_phase(lds, (LAS float*)(lds + EPI_P), Z + (size_t)2 * M * DG, Z + (size_t)3 * M * DG, Z + (size_t)4 * M * DG, rpb, g_ob, MIX, vcu, G, wave);
      }
        if (BOTH(3)) GRID_BAR();
    }
    if (IN(4)) {
        pg8::Gemm gm{MIX, WoutT, M, DM, DM}; pg8::StaticOrder S; S.init(M, DM, G, bx);
        pg8::EpiRes E{x, nullptr, nullptr, XA, nullptr, DM, epiP};
        pg8::gemm_phase<pg8::EpiRes, pg8::StaticOrder>(lds, gm, S, E, wave);
#if REP3 > 1
        __syncthreads(); pg8::gemm_phase<pg8::EpiRes, pg8::StaticOrder>(lds, gm, S, E, wave);
#endif
        if (BOTH(4)) GRID_BAR();
    }
    if (IN(5)) {
        const int lane = lane_id(), gw = vcu * 8 + wave, NGW = G * 8;
        for (int m = gw; m < M; m += NGW) {
            const u32x4* src = (const u32x4*)(XA + (size_t)m * DM) + lane;
            u32x4 w[8]; float mx = 0.f, ss = 0.f;
#pragma unroll
            for (int j = 0; j < 8; ++j) w[j] = src[64 * j];
#pragma unroll
            for (int j = 0; j < 8; ++j) { f32x4 a, b; pg8::bf8_to_f32(w[j], a, b); ss += pg8::sumsq4(a) + pg8::sumsq4(b);
                const f32x4 ab = __builtin_elementwise_max(__builtin_elementwise_abs(a), __builtin_elementwise_abs(b)); mx = fmaxf(mx, fmaxf(fmaxf(ab[0], ab[1]), fmaxf(ab[2], ab[3]))); }
            mx = wave_max(mx); ss = wave_sum(ss);
            const float inv = mx > 0.f ? 127.0f / mx : 0.f;
            u32x2* dst = (u32x2*)(A8H + (size_t)m * DM) + lane;
#pragma unroll
            for (int j = 0; j < 8; ++j) { f32x4 a, b; pg8::bf8_to_f32(w[j], a, b); u32x2 o; o.x = pg8::pk4_i8(a * inv); o.y = pg8::pk4_i8(b * inv); dst[64 * j] = o; }
            if (lane == 0) RSF[m] = rsqrtf(ss * (1.0f / DM) + EPS) * mx * (1.0f / 127.0f);
        }
        if (BOTH(5)) GRID_BAR();
    }
    if (IN(6)) {
        pg8::Gemm gm{(const bf16_t*)A8H, WupT, M, DUP, DM / 2}; pg8::StaticOrder S; S.init(M, DUP, G, bx);
        int rs_pm = -1;
        pg8::EpiUp E{ACT, RSF, CMAX, conv_w, conv_b, EDGE, epiRS, epiH, &rs_pm, epiP};
        pg8::gemm_phase<pg8::EpiUp, pg8::StaticOrder, false, 2>(lds, gm, S, E, wave);
        { pg8::Gemm gm2{PB, WpT, M, DM, DPLE}; pg8::TailOrder S2; S2.init_tail(M, DM, G, bx, (M / 256) * (DUP / 256));
          pg8::EpiRes E2{nullptr, nullptr, nullptr, EB, STE, DM, epiP};
          pg8::gemm_phase<pg8::EpiRes, pg8::TailOrder>(lds, gm2, S2, E2, wave); }
        if (BOTH(6)) GRID_BAR();
    }
    if (IN(7)) {
        const int gt = vcu * 512 + wave * 64 + lane_id(), NGT = G * 512;
        const int per_row = DFF / 4, total = 64 * 2 * per_row;
        for (int i = gt; i < total; i += NGT) {
            const int pr = i / per_row, j = (i - pr * per_row) * 4, pm = pr >> 1, which = pr & 1;
            const float* e0 = EDGE + (size_t)pm * 4 * DUP;
            f32x4 res[2];
#pragma unroll
            for (int bj = 0; bj < 2; ++bj) {
                const int ch = j + bj * DFF;
                f32x4 pv = {0.f, 0.f, 0.f, 0.f}, cv, nv = {0.f, 0.f, 0.f, 0.f};
                if (which == 0) { if (pm % 32 != 0) pv = *(const f32x4*)(e0 - (size_t)4 * DUP + (size_t)3 * DUP + ch); cv = *(const f32x4*)(e0 + ch); nv = *(const f32x4*)(e0 + (size_t)DUP + ch); }
                else { pv = *(const f32x4*)(e0 + (size_t)2 * DUP + ch); cv = *(const f32x4*)(e0 + (size_t)3 * DUP + ch); if (pm % 32 != 31) nv = *(const f32x4*)(e0 + (size_t)4 * DUP + ch); }
                res[bj] = *(const f32x4*)(conv_b + ch) + *(const f32x4*)(conv_w + ch) * pv + *(const f32x4*)(conv_w + DUP + ch) * cv + *(const f32x4*)(conv_w + 2 * DUP + ch) * nv;
            }
            const f32x4 a = pg8::gelu4(res[0]) * res[1];
            u32x2 o; o.x = pg8::cvt_pk_bf16(a[0], a[1]); o.y = pg8::cvt_pk_bf16(a[2], a[3]);
            *(u32x2*)(ACT + (size_t)(pm * 256 + (which ? 255 : 0)) * DFF + j) = o;
        }
        if (BOTH(7)) GRID_BAR();
    }
    if (IN(8)) {
        pg8::Gemm gm{ACT, WdnT, M, DM, DFF}; pg8::StaticOrder S; S.init(M, DM, G, bx);
        pg8::EpiRes E{nullptr, XA, nullptr, XA, nullptr, DM, epiP, nullptr};
        pg8::gemm_phase<pg8::EpiRes, pg8::StaticOrder>(lds, gm, S, E, wave);
        if (BOTH(8)) GRID_BAR();
    }
    if (IN(9)) {
        const int lane = lane_id(), gw = vcu * 8 + wave, NGW = G * 8;
        for (int m = gw; m < M; m += NGW) row_to_i8(XA, ws + WS_A8, RSB, m, lane);
        if (BOTH(9)) GRID_BAR();
    }
    if (IN(10)) {
        pg8::Gemm gm{(const bf16_t*)(ws + WS_A8), WgT, M, DM, DM / 2}; pg8::StaticOrder S; S.init(M, DM, G, bx);
        int rs_pm = -1;
        pg8::EpiGate E{out, XA, EB, RSB, STE, g_post, epiRS, &rs_pm, CMAXG};
        pg8::gemm_phase<pg8::EpiGate, pg8::StaticOrder, false, 2>(lds, gm, S, E, wave);
    }
#undef IN
#undef BOTH
#undef GRID_BAR
}

extern "C" void kernel_launch(void* const* d_in, const int* in_sizes, int n_in, void* d_out, int out_size, void* d_ws, size_t ws_size, hipStream_t stream) {
    static int grid = 0;
    if (grid == 0) {
        if (n_in != 22 || in_sizes[0] != M * DM || out_size != M * DM || ws_size < WS_END) { fprintf(stderr, "kernel_launch: unexpected shapes (n_in %d, in0 %d, out %d, ws %zu)\n", n_in, n_in > 0 ? in_sizes[0] : -1, out_size, ws_size); grid = -1; return; }
        int dev = 0, cus = 0, per_cu = 0;
        if (hipGetDevice(&dev) != hipSuccess || hipDeviceGetAttribute(&cus, hipDeviceAttributeMultiprocessorCount, dev) != hipSuccess) { grid = -1; return; }
        if (hipFuncSetAttribute((const void*)mk_fwd, hipFuncAttributeMaxDynamicSharedMemorySize, LDS_BYTES) != hipSuccess) { fprintf(stderr, "kernel_launch: hipFuncSetAttribute failed\n"); grid = -1; return; }
        if (hipOccupancyMaxActiveBlocksPerMultiprocessor(&per_cu, (const void*)mk_fwd, 512, LDS_BYTES) != hipSuccess || per_cu < 1) { fprintf(stderr, "kernel_launch: occupancy query says %d\n", per_cu); }
        (void)hipGetLastError();
        grid = cus;
    }
    if (grid < 0) return;
    if (hipMemsetAsync((char*)d_ws + WS_CTL, 0, CTL_ZERO_BYTES, stream) != hipSuccess) return;
    Args a{};
    for (int i = 0; i < 22; ++i) a.in[i] = (const float*)d_in[i];
    a.out = (float*)d_out; a.ws = (unsigned char*)d_ws;
    if (MK_N_LAUNCHES == 1) {
        a.ph_lo = 0; a.ph_hi = NPH;
        hipLaunchKernelGGL(mk_fwd, dim3(grid), dim3(512), LDS_BYTES, stream, a);
    } else {
        for (int k = 0; k < NPH; ++k) { a.ph_lo = k; a.ph_hi = k + 1; hipLaunchKernelGGL(mk_fwd, dim3(grid), dim3(512), LDS_BYTES, stream, a); }
    }
}
```
